# Optimizing an MI355X kernel written in HIP

```python
import math
import jax
import jax.numpy as jnp
from jax import lax
import numpy as np

D_MODEL = 1024
BATCH = 16
SEQ = 2048
DEPTH = 2

HEAD_DIM = 64
DIFF_HEADS = 4
DIFF_V_DIM = 2 * HEAD_DIM
NSA_HEADS = 8
NSA_KV_GROUPS = 2
CMP_LEN = 32
CMP_STRIDE = 16
CMP_HIDDEN = 256
SLC_BLOCK = 64
SLC_TOPK = 16
NSA_WINDOW = 512
FORCED_SCORE = 1e4
SWA_HEADS = 8
SWA_KV_HEADS = 2
SWA_WINDOW = 128
N_BRANCHES = 3
BRANCH_WIDTH = SWA_HEADS * HEAD_DIM
D_FF = ((8 * D_MODEL // 3 + 255) // 256) * 256
PLE_DIM = 256
QUERY_BLOCK = 128
SLC_QUERY_CHUNK = 32
LN_EPS = 1e-5
SUBLN_EPS = 1e-5
ALPHA = (2 * DEPTH) ** 0.25
BETA = (8 * DEPTH) ** -0.25
NEG_INF = -1e30

IN_SPLITS = (
    DIFF_HEADS * 2 * HEAD_DIM,
    DIFF_HEADS * 2 * HEAD_DIM,
    DIFF_HEADS * DIFF_V_DIM,
    NSA_HEADS * HEAD_DIM,
    2 * NSA_KV_GROUPS * HEAD_DIM,
    2 * NSA_KV_GROUPS * HEAD_DIM,
    2 * NSA_KV_GROUPS * HEAD_DIM,
    3 * NSA_HEADS,
    SWA_HEADS * HEAD_DIM,
    SWA_KV_HEADS * HEAD_DIM,
    SWA_KV_HEADS * HEAD_DIM,
    N_BRANCHES * D_MODEL,
)
D_IN = sum(IN_SPLITS)

kernel_name = 'hybrid_diff_nsa_swa_macaron_deepnorm'


def _split_offsets():
    offs, acc = [], 0
    for n in IN_SPLITS[:-1]:
        acc += n
        offs.append(acc)
    return offs


def layer_norm(x, g, b):
    xf = x.astype(jnp.float32)
    mu = jnp.mean(xf, axis=-1, keepdims=True)
    var = jnp.mean(jnp.square(xf - mu), axis=-1, keepdims=True)
    return ((xf - mu) * lax.rsqrt(var + LN_EPS) * g + b).astype(x.dtype)


def swiglu(x, w_in, w_out):
    gate, up = jnp.split(x @ w_in, 2, axis=-1)
    return (jax.nn.silu(gate) * up) @ w_out


def alibi_slopes(n_heads):
    return jnp.exp2(-8.0 * jnp.arange(1, n_heads + 1, dtype=jnp.float32) / n_heads)


def diff_attention(q, k, v, lam, subln_g, lambda_init):
    B, H, S, _, d = q.shape
    scale = d ** -0.5
    lam = lam.astype(jnp.float32)
    lam_full = jnp.exp(jnp.dot(lam[0], lam[1])) - jnp.exp(jnp.dot(lam[2], lam[3])) + lambda_init
    slopes = alibi_slopes(H)[None, :, None, None, None]
    kpos = jnp.arange(S)

    def block(i):
        start = i * QUERY_BLOCK
        q_blk = lax.dynamic_slice_in_dim(q, start, QUERY_BLOCK, axis=2)
        dist = (start + jnp.arange(QUERY_BLOCK))[:, None] - kpos[None, :]
        s = jnp.einsum('bhqmd,bhkmd->bhmqk', q_blk, k, preferred_element_type=jnp.float32) * scale
        s = jnp.where(dist >= 0, s - slopes * dist, NEG_INF)
        a = jax.nn.softmax(s, axis=-1)
        w = a[:, :, 0] - lam_full * a[:, :, 1]
        return jnp.einsum('bhqk,bhkv->bhqv', w.astype(v.dtype), v)

    o = lax.map(block, jnp.arange(S // QUERY_BLOCK))
    o = jnp.moveaxis(o, 0, 2).reshape(B, H, S, -1).astype(jnp.float32)
    o = o * lax.rsqrt(jnp.mean(o * o, axis=-1, keepdims=True) + SUBLN_EPS) * subln_g
    return (o * (1.0 - lambda_init)).astype(v.dtype)


def banded_attention(q, k, v, slopes, window, sinks=None):
    B, G, R, S, d = q.shape
    scale = d ** -0.5
    span = QUERY_BLOCK + window
    kp = jnp.pad(k, ((0, 0), (0, 0), (window, 0), (0, 0)))
    vp = jnp.pad(v, ((0, 0), (0, 0), (window, 0), (0, 0)))
    sl = slopes.reshape(G, R)[None, :, :, None, None]

    def block(i):
        start = i * QUERY_BLOCK
        q_blk = lax.dynamic_slice_in_dim(q, start, QUERY_BLOCK, axis=3)
        k_blk = lax.dynamic_slice_in_dim(kp, start, span, axis=2)
        v_blk = lax.dynamic_slice_in_dim(vp, start, span, axis=2)
        qpos = start + jnp.arange(QUERY_BLOCK)
        kpos = start - window + jnp.arange(span)
        dist = qpos[:, None] - kpos[None, :]
        valid = (dist >= 0) & (dist < window) & (kpos[None, :] >= 0)
        s = jnp.einsum('bgrqd,bgkd->bgrqk', q_blk, k_blk, preferred_element_type=jnp.float32) * scale
        s = jnp.where(valid, s - sl * dist, NEG_INF)
        if sinks is None:
            a = jax.nn.softmax(s, axis=-1)
        else:
            sink = jnp.broadcast_to(sinks.astype(jnp.float32).reshape(G, R)[None, :, :, None, None],
                                    s.shape[:-1] + (1,))
            a = jax.nn.softmax(jnp.concatenate([s, sink], axis=-1), axis=-1)[..., :-1]
        return jnp.einsum('bgrqk,bgkd->bgrqd', a.astype(v_blk.dtype), v_blk)

    o = lax.map(block, jnp.arange(S // QUERY_BLOCK))
    return jnp.moveaxis(o, 0, 4).reshape(B, G, R, S, d)


def nsa_attention(q, kv_cmp, kv_slc, kv_win, gates, cmp_pos, cmp_w1, cmp_w2):
    B, G, R, S, d = q.shape
    scale = d ** -0.5
    slopes = alibi_slopes(G * R)
    sl = slopes.reshape(G, R)[None, :, :, None, None]
    tpos = jnp.arange(S)

    n_cmp = (S - CMP_LEN) // CMP_STRIDE + 1
    c_start = jnp.arange(n_cmp) * CMP_STRIDE
    idx = c_start[:, None] + jnp.arange(CMP_LEN)[None, :]
    blocks = kv_cmp[:, :, :, idx] + cmp_pos[:, None, None, None]
    hid = jax.nn.gelu(jnp.einsum('nbgcf,nfh->nbgch',
                                 blocks.reshape(2, B, G, n_cmp, CMP_LEN * d), cmp_w1))
    k_c, v_c = jnp.einsum('nbgch,nhd->nbgcd', hid, cmp_w2)
    dist_c = tpos[:, None] - (c_start + CMP_LEN - 1)[None, :]
    valid_c = dist_c >= 0
    s_c = jnp.einsum('bgrtd,bgcd->bgrtc', q, k_c, preferred_element_type=jnp.float32) * scale
    s_c = jnp.where(valid_c, s_c - sl * dist_c, NEG_INF)
    p_c = jax.nn.softmax(s_c, axis=-1) * jnp.any(valid_c, axis=-1)[:, None]
    o_cmp = jnp.einsum('bgrtc,bgcd->bgrtd', p_c.astype(v_c.dtype), v_c)

    n_blk = S // SLC_BLOCK
    n_sel = min(SLC_TOPK, n_blk)
    j_start = jnp.arange(n_blk) * SLC_BLOCK
    overlap = (jnp.minimum(c_start[:, None] + CMP_LEN, j_start[None, :] + SLC_BLOCK)
               - jnp.maximum(c_start[:, None], j_start[None, :]))
    cmp_to_slc = jnp.maximum(overlap, 0).astype(jnp.float32) / CMP_LEN
    score = jnp.einsum('bgrtc,cj->bgtj', p_c, cmp_to_slc)
    t_blk = (tpos // SLC_BLOCK)[:, None]
    jj = jnp.arange(n_blk)[None, :]
    score = jnp.where((jj == 0) | (jj == t_blk) | (jj == t_blk - 1), FORCED_SCORE, score)
    score = jnp.where(jj > t_blk, -1.0, score)
    _, sel = lax.top_k(score, n_sel)

    k_s, v_s = kv_slc
    k_blk = k_s.reshape(B, G, n_blk, SLC_BLOCK, d)
    v_blk = v_s.reshape(B, G, n_blk, SLC_BLOCK, d)
    bi = jnp.arange(B)[:, None, None, None]
    gi = jnp.arange(G)[None, :, None, None]
    C = SLC_QUERY_CHUNK
    n_keys = n_sel * SLC_BLOCK

    def chunk(i):
        start = i * C
        q_c = lax.dynamic_slice_in_dim(q, start, C, axis=3)
        sel_c = lax.dynamic_slice_in_dim(sel, start, C, axis=2)
        kg = k_blk[bi, gi, sel_c].reshape(B, G, C, n_keys, d)
        vg = v_blk[bi, gi, sel_c].reshape(B, G, C, n_keys, d)
        kpos = (sel_c[..., None] * SLC_BLOCK + jnp.arange(SLC_BLOCK)).reshape(B, G, C, n_keys)
        dist = ((start + jnp.arange(C))[None, None, :, None] - kpos)[:, :, None]
        s = jnp.einsum('bgrcd,bgckd->bgrck', q_c, kg, preferred_element_type=jnp.float32) * scale
        s = jnp.where(dist >= 0, s - sl * dist, NEG_INF)
        a = jax.nn.softmax(s, axis=-1)
        return jnp.einsum('bgrck,bgckd->bgrcd', a.astype(vg.dtype), vg)

    o_slc = lax.map(chunk, jnp.arange(S // C))
    o_slc = jnp.moveaxis(o_slc, 0, 4).reshape(B, G, R, S, d)

    k_w, v_w = kv_win
    o_win = banded_attention(q, k_w, v_w, slopes, NSA_WINDOW)

    return gates[0] * o_cmp + gates[1] * o_slc + gates[2] * o_win


def _kv_heads(t, groups):
    B, S, _ = t.shape
    return t.reshape(B, S, 2, groups, HEAD_DIM).transpose(2, 0, 3, 1, 4)


def token_mixing(x, w_in, diff_lam, diff_subln_g, cmp_pos, cmp_w1, cmp_w2, sinks,
                 w_branch, w_out, lambda_init):
    B, S, _ = x.shape
    d = HEAD_DIM
    (a_q, a_k, a_v, b_q, b_kvc, b_kvs, b_kvw, b_g,
     c_q, c_k, c_v, m_g) = jnp.split(x @ w_in, _split_offsets(), axis=-1)

    qa = a_q.reshape(B, S, DIFF_HEADS, 2, d).transpose(0, 2, 1, 3, 4)
    ka = a_k.reshape(B, S, DIFF_HEADS, 2, d).transpose(0, 2, 1, 3, 4)
    va = a_v.reshape(B, S, DIFF_HEADS, DIFF_V_DIM).transpose(0, 2, 1, 3)
    o_a = diff_attention(qa, ka, va, diff_lam, diff_subln_g, lambda_init)
    o_a = o_a.transpose(0, 2, 1, 3).reshape(B, S, BRANCH_WIDTH)

    G, R = NSA_KV_GROUPS, NSA_HEADS // NSA_KV_GROUPS
    qb = b_q.reshape(B, S, G, R, d).transpose(0, 2, 3, 1, 4)
    gb = jax.nn.sigmoid(b_g.reshape(B, S, 3, G, R)).transpose(2, 0, 3, 4, 1)[..., None]
    o_b = nsa_attention(qb, _kv_heads(b_kvc, G), _kv_heads(b_kvs, G), _kv_heads(b_kvw, G),
                        gb, cmp_pos, cmp_w1, cmp_w2)
    o_b = o_b.transpose(0, 3, 1, 2, 4).reshape(B, S, BRANCH_WIDTH)

    Gc, Rc = SWA_KV_HEADS, SWA_HEADS // SWA_KV_HEADS
    qc = c_q.reshape(B, S, Gc, Rc, d).transpose(0, 2, 3, 1, 4)
    kc = c_k.reshape(B, S, Gc, d).transpose(0, 2, 1, 3)
    vc = c_v.reshape(B, S, Gc, d).transpose(0, 2, 1, 3)
    o_c = banded_attention(qc, kc, vc, alibi_slopes(SWA_HEADS), SWA_WINDOW, sinks)
    o_c = o_c.transpose(0, 3, 1, 2, 4).reshape(B, S, BRANCH_WIDTH)

    y = jnp.einsum('bsnc,ncd->bsnd', jnp.stack([o_a, o_b, o_c], axis=2), w_branch)
    g = jax.nn.sigmoid(m_g.reshape(B, S, N_BRANCHES, D_MODEL))
    return jnp.einsum('bsnd,bsnd->bsd', g, y) @ w_out


def setup_inputs(seed: int = 0) -> dict:
    key = jax.random.key(seed)
    ks = jax.random.split(key, 17)
    f32 = jnp.float32

    def nrm(k, shape, scale):
        return jax.random.normal(k, shape, f32) * scale

    return {
        'x': nrm(ks[0], (BATCH, SEQ, D_MODEL), 1.0),
        'p': nrm(ks[1], (DEPTH, BATCH, SEQ, PLE_DIM), 1.0),
        'ffn_w_in': nrm(ks[2], (DEPTH, 2, D_MODEL, 2 * D_FF), D_MODEL ** -0.5),
        'ffn_w_out': nrm(ks[3], (DEPTH, 2, D_FF, D_MODEL), BETA * D_FF ** -0.5),
        'ln_g': 1.0 + nrm(ks[4], (DEPTH, 3, D_MODEL), 0.05),
        'ln_b': nrm(ks[5], (DEPTH, 3, D_MODEL), 0.02),
        'w_in': nrm(ks[6], (DEPTH, D_MODEL, D_IN), D_MODEL ** -0.5),
        'diff_lam': nrm(ks[7], (DEPTH, 4, HEAD_DIM), 0.1),
        'diff_subln_g': 1.0 + nrm(ks[8], (DEPTH, DIFF_V_DIM), 0.05),
        'nsa_cmp_pos': nrm(ks[9], (DEPTH, 2, CMP_LEN, HEAD_DIM), 0.1),
        'nsa_cmp_w1': nrm(ks[10], (DEPTH, 2, CMP_LEN * HEAD_DIM, CMP_HIDDEN), (CMP_LEN * HEAD_DIM) ** -0.5),
        'nsa_cmp_w2': nrm(ks[11], (DEPTH, 2, CMP_HIDDEN, HEAD_DIM), CMP_HIDDEN ** -0.5),
        'swa_sinks': nrm(ks[12], (DEPTH, SWA_HEADS), 0.5),
        'w_branch': nrm(ks[13], (DEPTH, N_BRANCHES, BRANCH_WIDTH, D_MODEL), BETA * BRANCH_WIDTH ** -0.5),
        'w_out': nrm(ks[14], (DEPTH, D_MODEL, D_MODEL), BETA * D_MODEL ** -0.5),
        'ple_w_in': nrm(ks[15], (DEPTH, PLE_DIM, D_MODEL), BETA * PLE_DIM ** -0.5),
        'ple_w_gate': nrm(ks[16], (DEPTH, D_MODEL, D_MODEL), D_MODEL ** -0.5),
    }


def reference(x, p, ffn_w_in, ffn_w_out, ln_g, ln_b, w_in, diff_lam, diff_subln_g,
              nsa_cmp_pos, nsa_cmp_w1, nsa_cmp_w2, swa_sinks, w_branch, w_out,
              ple_w_in, ple_w_gate):
    for i in range(DEPTH):
        lambda_init = 0.8 - 0.6 * math.exp(-0.3 * i)
        x = layer_norm(ALPHA * x + 0.5 * swiglu(x, ffn_w_in[i, 0], ffn_w_out[i, 0]),
                       ln_g[i, 0], ln_b[i, 0])
        mix = token_mixing(x, w_in[i], diff_lam[i], diff_subln_g[i], nsa_cmp_pos[i],
                           nsa_cmp_w1[i], nsa_cmp_w2[i], swa_sinks[i], w_branch[i],
                           w_out[i], lambda_init)
        x = layer_norm(ALPHA * x + mix, ln_g[i, 1], ln_b[i, 1])
        h = ALPHA * x + 0.5 * swiglu(x, ffn_w_in[i, 1], ffn_w_out[i, 1])
        h = h + jax.nn.sigmoid(h @ ple_w_gate[i]) * (p[i] @ ple_w_in[i])
        x = layer_norm(h, ln_g[i, 2], ln_b[i, 2])
    return x
```

```cpp
#include <hip/hip_runtime.h>
#include <hip/hip_cooperative_groups.h>
#include <cstdio>
#include <cstdint>
namespace cg = cooperative_groups;

#define LAS __attribute__((address_space(3)))
typedef unsigned short bf16_t;
typedef short bf16x8 __attribute__((ext_vector_type(8)));
typedef float f32x4 __attribute__((ext_vector_type(4)));
typedef float f32x16 __attribute__((ext_vector_type(16)));
typedef unsigned u32x4 __attribute__((ext_vector_type(4)));
typedef unsigned u32x2 __attribute__((ext_vector_type(2)));

#ifndef DBG_ZERO
#define DBG_ZERO 0
#endif
#ifndef STATIC_QUEUE
#define STATIC_QUEUE 0
#endif
#ifndef N_LAUNCH_MODE
#define N_LAUNCH_MODE 0
#endif

constexpr int T = 32768, DM = 1024, SEQ = 2048, NB = 16, DFF = 2816, PLE = 256;
constexpr int LDQ = 2816;
constexpr int QA = 0, KA = 512, QB = 1024, KVC = 1536, KS = 1792, KWC = 1920, QC = 2048, KCC = 2560, BG = 2688;
constexpr int VA = 0, VS = 512, VW = 640, VC = 768;
constexpr int DIN = 6680;
constexpr float LOG2E = 1.4426950408889634f;
constexpr float QSCALE = 0.125f * LOG2E;
constexpr float ALPHA = 1.4142135623730951f;
constexpr float NINF = -__builtin_inff();
constexpr int LDS_BYTES = 147456;

constexpr size_t WS_CTL = 0;
constexpr size_t WS_CB = 4096;
constexpr size_t WS_CBP = WS_CB + 2048;
constexpr size_t WS_W = WS_CBP + 64 * 512 * 4;
constexpr size_t W_F1A = 0, W_F1B = W_F1A + 5767168, W_F2A = W_F1B + 2883584, W_F2B = W_F2A + 5767168, W_TOK = W_F2B + 2883584,
                 W_VT = W_TOK + 2883584, W_MG = W_VT + 1048576, W_BR = W_MG + 3145728, W_O = W_BR + 1572864, W_PI = W_O + 1048576,
                 W_PG = W_PI + 262144, W_C1 = W_PG + 1048576, W_C2 = W_C1 + 1048576, W_END = W_C2 + 32768;
constexpr size_t WS_PB = WS_W + W_END * 2;
constexpr size_t WS_XB = WS_PB + (size_t)T * PLE * 2;
constexpr size_t WS_A = WS_XB + (size_t)T * DM * 2;
constexpr size_t WS_VT = WS_A + (size_t)T * LDQ * 2;
constexpr size_t WS_B = WS_A + (size_t)T * LDQ * 2 + (size_t)1024 * T * 2;
constexpr size_t WS_KC = WS_B + (size_t)T * DM * 4;
constexpr size_t WS_VCT = WS_KC + 524288;
constexpr size_t WS_HID = WS_VCT + 524288;
constexpr size_t WS_SEL = WS_HID + 4194304;
constexpr size_t WS_WIN = WS_B + (size_t)T * 1536 * 2;
constexpr size_t WS_END = WS_SEL + 262144;

struct Args {
    const float* in[17];
    float* out; unsigned char* ws;
    int ph_lo, ph_hi;
};

#define CAS __attribute__((address_space(4)))
__device__ __forceinline__ Args load_args() {
#if defined(__HIP_DEVICE_COMPILE__)
    const CAS Args* kp = (const CAS Args*)__builtin_amdgcn_kernarg_segment_ptr();
    asm volatile("" : "+s"(kp));
    Args r;
#pragma unroll
    for (int i = 0; i < 17; ++i) r.in[i] = kp->in[i];
    r.out = kp->out; r.ws = kp->ws; r.ph_lo = kp->ph_lo; r.ph_hi = kp->ph_hi;
    return r;
#else
    return Args{};
#endif
}
template <class X> __device__ __forceinline__ X launder_s(X v) { asm volatile("" : "+s"(v)); return v; }
__device__ __forceinline__ int my_tid() { int t = threadIdx.x; asm volatile("" : "+v"(t)); return t; }
typedef float f32x2_t __attribute__((ext_vector_type(2)));
typedef __bf16 bf16x2_t __attribute__((ext_vector_type(2)));
__device__ __forceinline__ unsigned pk2(float lo, float hi) { const f32x2_t v = {lo, hi}; return __builtin_bit_cast(unsigned, __builtin_convertvector(v, bf16x2_t)); }
__device__ __forceinline__ float bf2f(bf16_t v) { return __uint_as_float(((unsigned)v) << 16); }
__device__ __forceinline__ float bflo(unsigned w) { return __uint_as_float(w << 16); }
__device__ __forceinline__ float bfhi(unsigned w) { return __uint_as_float(w & 0xffff0000u); }
__device__ __forceinline__ float fexp2(float x) { return __builtin_amdgcn_exp2f(x); }
__device__ __forceinline__ float frcp(float x) { return __builtin_amdgcn_rcpf(x); }
__device__ __forceinline__ float sigmoidf_(float x) { return frcp(1.0f + fexp2(-x * LOG2E)); }
__device__ __forceinline__ float gelu_tanh(float x) { const float u = 1.5957691216057308f * (x + 0.044715f * x * x * x); return x * sigmoidf_(u); }
__device__ __forceinline__ f32x16 zero16() {
    f32x16 z;
#pragma unroll
    for (int i = 0; i < 16; ++i) z[i] = 0.f;
    asm volatile("" : "+v"(z));
    return z;
}
__device__ __forceinline__ f32x16 mfma32(bf16x8 a, bf16x8 b, f32x16 c) { return __builtin_amdgcn_mfma_f32_32x32x16_bf16(a, b, c, 0, 0, 0); }
__device__ __forceinline__ float wave_sum(float v) {
#pragma unroll
    for (int o = 1; o < 64; o <<= 1) v += __shfl_xor(v, o);
    return v;
}

namespace pg8 {
constexpr int BM = 256, BK = 64, HALF = 128, HTB = HALF * BK * 2, NXCD = 8, WGM = 8;
__device__ __forceinline__ int lds_byte(int r, int c) { const int st = (r >> 4) * 2 + (c >> 5), rr = r & 15, cc = c & 31, ob = rr * 64 + cc * 2; return st * 1024 + (ob ^ (((ob >> 9) & 1) << 5)); }
__device__ __forceinline__ void stage_rc(int b, int& R, int& C) { const int st = b / 1024, sb = b % 1024, swz = sb ^ (((sb >> 9) & 1) << 5); R = (st >> 1) * 16 + swz / 64; C = (st & 1) * 32 + (swz % 64) / 2; }
__device__ __forceinline__ int perm32(int rho) { const int n = rho >> 4, i = rho & 15; return 8 * (i >> 2) + 4 * n + (i & 3); }
}
enum { EP_SWIGLU = 0, EP_RES = 1, EP_BF16 = 2, EP_SIG16 = 3, EP_BRANCH = 4, EP_GELU = 5, EP_PE16 = 6, EP_PLEGATE = 7 };
struct GemmDesc {
    const char* A; const char* Bt;
    unsigned lda, ldb, ksA;
    int nt, nM, nN, nz, cmp, perm, mode;
    size_t a_tile, b_tile, a_z, b_z;
    float* f0; const float* xres; bf16_t* o16; const float* bias;
    int ldc; float scale;
};
struct Unit { int pm, pn, z; const char* a; const char* b; };

__device__ __forceinline__ bool gnext(const GemmDesc& g, int c, int G, int i, Unit& u) {
    if (g.cmp) {
        if (i != 0 || c >= 32) return false;
        const int n = c >> 4, rt = c & 15; u.pm = rt; u.pn = 0; u.z = n;
        u.a = g.A + n * 256 + (rt >> 3) * 128 + (size_t)(rt & 7) * g.a_tile; u.b = g.Bt + (size_t)n * g.b_z; return true;
    }
    int ti = i, z = 0; if (g.nz > 1) { ti = i / g.nz; z = i - ti * g.nz; }
    const int nwg = g.nM * g.nN; const long L = (long)ti * G + c; if (L >= nwg) return false;
    int wgid = (int)L; { const int q = nwg / pg8::NXCD, r = nwg % pg8::NXCD, xcd = wgid % pg8::NXCD, off = wgid / pg8::NXCD; wgid = (xcd < r ? xcd * (q + 1) : r * (q + 1) + (xcd - r) * q) + off; }
    const int nig = pg8::WGM * g.nN, gid = wgid / nig, fm = gid * pg8::WGM, gsz = (g.nM - fm) < pg8::WGM ? (g.nM - fm) : pg8::WGM;
    u.pm = fm + ((wgid % nig) % gsz); u.pn = (wgid % nig) / gsz; u.z = z;
    u.a = g.A + (size_t)u.pm * g.a_tile + (size_t)z * g.a_z; u.b = g.Bt + (size_t)u.pn * g.b_tile + (size_t)z * g.b_z; return true;
}

__device__ __forceinline__ void gemm_epilogue(const GemmDesc& g, const f32x4 (&acc)[2][2][4][2], const Unit& u, int wr, int wc, int fr, int fq) {
    const int row0 = u.pm * 256 + wr * 64 + fr;
    if (g.mode == EP_SWIGLU) {
        const int col0 = u.pn * 128 + wc * 32 + 8 * fq;
#pragma unroll
        for (int ai = 0; ai < 2; ++ai)
#pragma unroll
            for (int m = 0; m < 4; ++m) {
                float o[8];
#pragma unroll
                for (int n = 0; n < 2; ++n)
#pragma unroll
                    for (int j = 0; j < 4; ++j) { const float gt = acc[ai][0][m][n][j], up = acc[ai][1][m][n][j]; o[4 * n + j] = gt * sigmoidf_(gt) * up; }
                u32x4 w; w.x = pk2(o[0], o[1]); w.y = pk2(o[2], o[3]); w.z = pk2(o[4], o[5]); w.w = pk2(o[6], o[7]);
                *(u32x4*)(g.o16 + (size_t)(row0 + ai * 128 + m * 16) * g.ldc + col0) = w;
            }
    } else if (g.mode == EP_BF16 || g.mode == EP_SIG16 || g.mode == EP_GELU) {
        const int col0 = u.pn * 256 + wc * 32 + 8 * fq;
        bf16_t* base = g.o16; f32x4 bv[2][2];
#pragma unroll
        for (int bj = 0; bj < 2; ++bj)
#pragma unroll
            for (int n = 0; n < 2; ++n) bv[bj][n] = (f32x4){0.f, 0.f, 0.f, 0.f};
        if (g.mode == EP_GELU) {
            base += (size_t)u.z * 4096 * 256;
#pragma unroll
            for (int bj = 0; bj < 2; ++bj)
#pragma unroll
                for (int n = 0; n < 2; ++n) bv[bj][n] = *(const f32x4*)(g.bias + u.z * 256 + col0 + bj * 128 + 4 * n);
        }
#pragma unroll
        for (int ai = 0; ai < 2; ++ai)
#pragma unroll
            for (int m = 0; m < 4; ++m) {
                bf16_t* rowp = base + (size_t)(row0 + ai * 128 + m * 16) * g.ldc + col0;
#pragma unroll
                for (int bj = 0; bj < 2; ++bj) {
                    f32x4 v0 = acc[ai][bj][m][0] + bv[bj][0], v1 = acc[ai][bj][m][1] + bv[bj][1];
                    if (g.mode == EP_SIG16) {
#pragma unroll
                        for (int j = 0; j < 4; ++j) { v0[j] = sigmoidf_(v0[j]); v1[j] = sigmoidf_(v1[j]); }
                    } else if (g.mode == EP_GELU) {
#pragma unroll
                        for (int j = 0; j < 4; ++j) { v0[j] = gelu_tanh(v0[j]); v1[j] = gelu_tanh(v1[j]); }
                    }
                    u32x4 w; w.x = pk2(v0[0], v0[1]); w.y = pk2(v0[2], v0[3]); w.z = pk2(v1[0], v1[1]); w.w = pk2(v1[2], v1[3]);
                    *(u32x4*)(rowp + bj * 128) = w;
                }
            }
    } else if (g.mode == EP_BRANCH) {
        const int col0 = u.pn * 256 + wc * 32 + 8 * fq;
#pragma unroll
        for (int ai = 0; ai < 2; ++ai)
#pragma unroll
            for (int m = 0; m < 4; ++m) {
                bf16_t* rowp = g.o16 + (size_t)(row0 + ai * 128 + m * 16) * g.ldc + col0;
#pragma unroll
                for (int bj = 0; bj < 2; ++bj) {
                    const u32x4 gw = *(const u32x4*)(rowp + u.z * 1024 + bj * 128);
                    f32x4 v0 = acc[ai][bj][m][0], v1 = acc[ai][bj][m][1];
                    v0[0] *= bflo(gw.x); v0[1] *= bfhi(gw.x); v0[2] *= bflo(gw.y); v0[3] *= bfhi(gw.y);
                    v1[0] *= bflo(gw.z); v1[1] *= bfhi(gw.z); v1[2] *= bflo(gw.w); v1[3] *= bfhi(gw.w);
                    if (u.z > 0) {
                        const u32x4 pw = *(const u32x4*)(rowp + bj * 128);
                        v0[0] += bflo(pw.x); v0[1] += bfhi(pw.x); v0[2] += bflo(pw.y); v0[3] += bfhi(pw.y);
                        v1[0] += bflo(pw.z); v1[1] += bfhi(pw.z); v1[2] += bflo(pw.w); v1[3] += bfhi(pw.w);
                    }
                    u32x4 w; w.x = pk2(v0[0], v0[1]); w.y = pk2(v0[2], v0[3]); w.z = pk2(v1[0], v1[1]); w.w = pk2(v1[2], v1[3]);
                    *(u32x4*)(rowp + bj * 128) = w;
                }
            }
    } else {
        const int col0 = u.pn * 256 + wc * 32 + 4 * fq;
#pragma unroll
        for (int ai = 0; ai < 2; ++ai)
#pragma unroll
            for (int m = 0; m < 4; ++m) {
                const size_t off = (size_t)(row0 + ai * 128 + m * 16) * g.ldc + col0;
#pragma unroll
                for (int bj = 0; bj < 2; ++bj)
#pragma unroll
                    for (int n = 0; n < 2; ++n) {
                        const size_t o = off + bj * 128 + n * 16; const f32x4 a = acc[ai][bj][m][n];
                        if (g.mode == EP_RES) {
                            const f32x4 xr = *(const f32x4*)(g.xres + o); const f32x4 v = xr * ALPHA + a * g.scale;
                            *(f32x4*)(g.f0 + o) = v;
                            if (g.o16) { u32x2 w; w.x = pk2(v[0], v[1]); w.y = pk2(v[2], v[3]); *(u32x2*)(g.o16 + o) = w; }
                        } else if (g.mode == EP_PE16) {
                            u32x2 w; w.x = pk2(a[0], a[1]); w.y = pk2(a[2], a[3]); *(u32x2*)(g.o16 + o) = w;
                        } else {
                            const u32x2 pw = *(const u32x2*)(g.o16 + o); f32x4 v = *(const f32x4*)(g.f0 + o);
                            v[0] += sigmoidf_(a[0]) * bflo(pw.x); v[1] += sigmoidf_(a[1]) * bfhi(pw.x); v[2] += sigmoidf_(a[2]) * bflo(pw.y); v[3] += sigmoidf_(a[3]) * bfhi(pw.y);
                            *(f32x4*)(g.f0 + o) = v;
                        }
                    }
            }
    }
}

__device__ __forceinline__ void gd_build(GemmDesc& g, const Args& a, int l, int p, int gi);
__device__ __forceinline__ void gemm_phase(LAS unsigned char* lds, int l, int p, int gi, int c, int G) {
    using namespace pg8;
    const int tid = my_tid(), wid = __builtin_amdgcn_readfirstlane(tid >> 6), lane = tid & 63, wr = wid >> 2, wc = wid & 3, fr = lane & 15, fq = lane >> 4;
    Unit cur, nxt; int ui = 0;
    unsigned voffA[2], voffB[2]; int nt; size_t kstepA, hstepA, hstepB; const size_t kstepB = 128;
    { GemmDesc g; gd_build(g, load_args(), l, p, gi);
      if (!gnext(g, c, G, 0, cur)) return;
      nt = g.nt;
#pragma unroll
      for (int i = 0; i < 2; ++i) { int R, C; stage_rc(tid * 16 + i * 8192, R, C); const int Rb = g.perm ? ((R & ~31) + perm32(R & 31)) : R;
          voffA[i] = (unsigned)(R * g.lda + C) * 2u; voffB[i] = (unsigned)(Rb * g.ldb + C) * 2u; }
      kstepA = g.ksA; hstepA = (size_t)HALF * g.lda * 2; hstepB = (size_t)HALF * g.ldb * 2; }
    const unsigned ldsw = (unsigned)wid * 1024u;
    const int aoff = lds_byte(wr * 64 + fr, fq * 8), boff = lds_byte(wc * 32 + fr, fq * 8);
#define PG8_SA(b, h) (((b) * 2 + (h)) * HTB)
#define PG8_SB(b, h) ((4 + (b) * 2 + (h)) * HTB)
#define PG8_STAGE(bufoff, gbase, voff) do { _Pragma("unroll") for (int _i = 0; _i < 2; ++_i) \
        __builtin_amdgcn_global_load_lds((const unsigned*)((const char*)(gbase) + (voff)[_i]), (LAS unsigned*)(lds + (bufoff) + ldsw + _i * 8192), 16, 0, 0); } while (0)
#define PG8_LDA(dst, b, h) do { _Pragma("unroll") for (int m = 0; m < 4; ++m) _Pragma("unroll") for (int k = 0; k < 2; ++k) dst[m][k] = *(const LAS bf16x8*)(lds + PG8_SA(b, h) + aoff + m * 2048 + k * 1024); } while (0)
#define PG8_LDB(dst, b, h) do { _Pragma("unroll") for (int n = 0; n < 2; ++n) _Pragma("unroll") for (int k = 0; k < 2; ++k) dst[n][k] = *(const LAS bf16x8*)(lds + PG8_SB(b, h) + boff + n * 2048 + k * 1024); } while (0)
#define PG8_MMA(ai, bj, At, Bt) do { __builtin_amdgcn_s_setprio(1); _Pragma("unroll") for (int m = 0; m < 4; ++m) _Pragma("unroll") for (int n = 0; n < 2; ++n) _Pragma("unroll") for (int k = 0; k < 2; ++k) \
        acc[ai][bj][m][n] = __builtin_amdgcn_mfma_f32_16x16x32_bf16(Bt[n][k], At[m][k], acc[ai][bj][m][n], 0, 0, 0); __builtin_amdgcn_s_setprio(0); } while (0)
#define PG8_WAIT_V(n) asm volatile("s_waitcnt vmcnt(" #n ")" ::: "memory")
#define PG8_WAIT_L(n) asm volatile("s_waitcnt lgkmcnt(" #n ")" ::: "memory")
#define PG8_BAR __builtin_amdgcn_s_barrier()
#define PG8_SCHED __builtin_amdgcn_sched_barrier(0)
    f32x4 acc[2][2][4][2];
#pragma unroll
    for (int a = 0; a < 2; ++a)
#pragma unroll
        for (int b = 0; b < 2; ++b)
#pragma unroll
            for (int m = 0; m < 4; ++m)
#pragma unroll
                for (int n = 0; n < 2; ++n) acc[a][b][m][n] = (f32x4){0.f, 0.f, 0.f, 0.f};
    bf16x8 At[4][2], B0[2][2], B1[2][2];
    const char* cA = cur.a; const char* cB = cur.b;
    PG8_STAGE(PG8_SB(0, 0), cB, voffB); PG8_STAGE(PG8_SA(0, 0), cA, voffA); PG8_STAGE(PG8_SB(0, 1), cB + hstepB, voffB); PG8_STAGE(PG8_SA(0, 1), cA + hstepA, voffA);
    if (wr == 1) PG8_BAR;
    PG8_WAIT_V(4); PG8_BAR;
    PG8_STAGE(PG8_SB(1, 0), cB + kstepB, voffB); PG8_STAGE(PG8_SA(1, 0), cA + kstepA, voffA); PG8_STAGE(PG8_SB(1, 1), cB + hstepB + kstepB, voffB);
    PG8_WAIT_V(6); PG8_BAR;
    for (;;) {
        bool has_next; { GemmDesc g; gd_build(g, load_args(), launder_s(l), p, gi); has_next = gnext(g, c, G, ui + 1, nxt); }
        const char* nA = has_next ? nxt.a : cA; const char* nB = has_next ? nxt.b : cB;
        for (int t = 0; t < nt; t += 2) {
            const bool last = (t == nt - 2);
            const char* a1 = cA + (size_t)(t + 1) * kstepA;
            const char* a2 = last ? nA : cA + (size_t)(t + 2) * kstepA; const char* b2 = last ? nB : cB + (size_t)(t + 2) * kstepB;
            const char* a3 = a2 + kstepA; const char* b3 = b2 + kstepB;
            PG8_LDB(B0, 0, 0); PG8_SCHED; PG8_LDA(At, 0, 0); PG8_STAGE(PG8_SA(1, 1), a1 + hstepA, voffA);
            PG8_WAIT_L(8); PG8_BAR; PG8_WAIT_L(0); PG8_MMA(0, 0, At, B0); PG8_BAR; PG8_SCHED;
            PG8_LDB(B1, 0, 1); PG8_STAGE(PG8_SB(0, 0), b2, voffB);
            PG8_BAR; PG8_WAIT_L(0); PG8_MMA(0, 1, At, B1); PG8_BAR;
            PG8_LDA(At, 0, 1); PG8_STAGE(PG8_SA(0, 0), a2, voffA);
            PG8_BAR; PG8_WAIT_L(0); PG8_MMA(1, 0, At, B0); PG8_BAR; PG8_SCHED;
            PG8_STAGE(PG8_SB(0, 1), b2 + hstepB, voffB);
            PG8_WAIT_V(6); PG8_BAR; PG8_MMA(1, 1, At, B1); PG8_BAR;
            PG8_LDB(B0, 1, 0); PG8_SCHED; PG8_LDA(At, 1, 0); PG8_STAGE(PG8_SA(0, 1), a2 + hstepA, voffA);
            PG8_WAIT_L(8); PG8_BAR; PG8_WAIT_L(0); PG8_MMA(0, 0, At, B0); PG8_BAR; PG8_SCHED;
            PG8_LDB(B1, 1, 1); PG8_STAGE(PG8_SB(1, 0), b3, voffB);
            PG8_BAR; PG8_WAIT_L(0); PG8_MMA(0, 1, At, B1); PG8_BAR;
            PG8_LDA(At, 1, 1); PG8_STAGE(PG8_SA(1, 0), a3, voffA);
            PG8_BAR; PG8_WAIT_L(0); PG8_MMA(1, 0, At, B0); PG8_BAR; PG8_SCHED;
            PG8_STAGE(PG8_SB(1, 1), b3 + hstepB, voffB);
            PG8_WAIT_V(6); PG8_BAR; PG8_MMA(1, 1, At, B1); PG8_BAR;
        }
        { GemmDesc g; gd_build(g, load_args(), launder_s(l), p, gi); gemm_epilogue(g, acc, cur, wr, wc, fr, fq); }
        if (!has_next) break;
#pragma unroll
        for (int a = 0; a < 2; ++a)
#pragma unroll
            for (int b = 0; b < 2; ++b)
#pragma unroll
                for (int m = 0; m < 4; ++m)
#pragma unroll
                    for (int n = 0; n < 2; ++n) acc[a][b][m][n] = (f32x4){0.f, 0.f, 0.f, 0.f};
        cur = nxt; cA = nA; cB = nB; ++ui;
    }
    PG8_WAIT_V(0);
    if (wr == 0) PG8_BAR;
    PG8_BAR;
#undef PG8_SA
#undef PG8_SB
#undef PG8_STAGE
#undef PG8_LDA
#undef PG8_LDB
#undef PG8_MMA
#undef PG8_WAIT_V
#undef PG8_WAIT_L
#undef PG8_BAR
#undef PG8_SCHED
}

enum { MAP_ID = 0, MAP_FFN = 1, MAP_TOK = 2, MAP_VT = 3, MAP_MG = 4 };
__device__ __forceinline__ int map_col(int map, int n, float& sc) {
    sc = 1.0f;
    if (map == MAP_ID) return n;
    if (map == MAP_FFN) { const int pn = n >> 8, half = (n >> 7) & 1, idx = n & 127; return half * DFF + pn * 128 + idx; }
    if (map == MAP_MG) return 3608 + n;
    if (map == MAP_VT) { if (n < 512) return 1024 + n; if (n < 640) return 2432 + (n - 512); if (n < 768) return 2688 + (n - 640); if (n < 896) return 3480 + (n - 768); return -1; }
    if (n < 512) { sc = QSCALE; return n; }
    if (n < 1024) return n;
    if (n < 1536) { sc = QSCALE; return 1536 + (n - 1024); }
    if (n < 1792) return 2048 + (n - 1536);
    if (n < 1920) return 2304 + (n - 1792);
    if (n < 2048) return 2560 + (n - 1920);
    if (n < 2560) { sc = QSCALE; return 2840 + (n - 2048); }
    if (n < 2688) return 3352 + (n - 2560);
    if (n < 2712) return 2816 + (n - 2688);
    return -1;
}
__device__ __forceinline__ void transpose_item(const float* W, int ldw, int K, int N, bf16_t* WT, int map, LAS float* scr, int item, int lane) {
    const int nblk = N / 32, kb = item / nblk, nb = item % nblk, k0 = 64 * kb, n0 = 32 * nb;
    float sc; const int sc_col = map_col(map, n0 + (lane & 31), sc);
#pragma unroll 8
    for (int i = 0; i < 32; ++i) { const int kk = 2 * i + (lane >> 5); scr[kk * 33 + (lane & 31)] = sc_col >= 0 ? W[(size_t)(k0 + kk) * ldw + sc_col] * sc : 0.f; }
    asm volatile("s_waitcnt lgkmcnt(0)" ::: "memory");
    const int cch = lane & 7;
#pragma unroll
    for (int j = 0; j < 4; ++j) { const int n = (lane >> 3) + 8 * j; const LAS float* s = scr + (8 * cch) * 33 + n;
        u32x4 o; o.x = pk2(s[0 * 33], s[1 * 33]); o.y = pk2(s[2 * 33], s[3 * 33]); o.z = pk2(s[4 * 33], s[5 * 33]); o.w = pk2(s[6 * 33], s[7 * 33]);
        *(u32x4*)(WT + (size_t)(n0 + n) * K + k0 + 8 * cch) = o; }
    asm volatile("s_waitcnt lgkmcnt(0)" ::: "memory");
}
struct ConvJob { const float* W; int ldw, K, N, map; bf16_t* WT; };
__device__ __forceinline__ void get_job(const Args& a, int l, int j, ConvJob& q) {
    bf16_t* wb = (bf16_t*)(a.ws + WS_W);
    const float* ffn_in = a.in[2] + (size_t)l * 2 * DM * 2 * DFF; const float* ffn_out = a.in[3] + (size_t)l * 2 * DFF * DM;
    const float* w_in = a.in[6] + (size_t)l * DM * DIN;
    const float* w1 = a.in[10] + (size_t)l * 2 * 2048 * 256; const float* w2 = a.in[11] + (size_t)l * 2 * 256 * 64;
    q.map = MAP_ID;
    switch (j) {
    case 0: q.W = ffn_in; q.ldw = 2 * DFF; q.K = DM; q.N = 2 * DFF; q.WT = wb + W_F1A; q.map = MAP_FFN; break;
    case 1: q.W = ffn_in + (size_t)DM * 2 * DFF; q.ldw = 2 * DFF; q.K = DM; q.N = 2 * DFF; q.WT = wb + W_F2A; q.map = MAP_FFN; break;
    case 2: q.W = ffn_out; q.ldw = DM; q.K = DFF; q.N = DM; q.WT = wb + W_F1B; break;
    case 3: q.W = ffn_out + (size_t)DFF * DM; q.ldw = DM; q.K = DFF; q.N = DM; q.WT = wb + W_F2B; break;
    case 4: q.W = w_in; q.ldw = DIN; q.K = DM; q.N = 2816; q.WT = wb + W_TOK; q.map = MAP_TOK; break;
    case 5: q.W = w_in; q.ldw = DIN; q.K = DM; q.N = 1024; q.WT = wb + W_VT; q.map = MAP_VT; break;
    case 6: q.W = w_in; q.ldw = DIN; q.K = DM; q.N = 3072; q.WT = wb + W_MG; q.map = MAP_MG; break;
    case 7: q.W = a.in[13] + (size_t)l * 1536 * DM; q.ldw = DM; q.K = 1536; q.N = DM; q.WT = wb + W_BR; break;
    case 8: q.W = a.in[14] + (size_t)l * DM * DM; q.ldw = DM; q.K = DM; q.N = DM; q.WT = wb + W_O; break;
    case 9: q.W = a.in[15] + (size_t)l * PLE * DM; q.ldw = DM; q.K = PLE; q.N = DM; q.WT = wb + W_PI; break;
    case 10: q.W = a.in[16] + (size_t)l * DM * DM; q.ldw = DM; q.K = DM; q.N = DM; q.WT = wb + W_PG; break;
    case 11: q.W = w1; q.ldw = 256; q.K = 2048; q.N = 256; q.WT = wb + W_C1; break;
    case 12: q.W = w1 + 2048 * 256; q.ldw = 256; q.K = 2048; q.N = 256; q.WT = wb + W_C1 + 256 * 2048; break;
    case 13: q.W = w2; q.ldw = 64; q.K = 256; q.N = 64; q.WT = wb + W_C2; break;
    default: q.W = w2 + 256 * 64; q.ldw = 64; q.K = 256; q.N = 64; q.WT = wb + W_C2 + 64 * 256; break;
    }
}
__device__ __forceinline__ void convert_layer(const Args& a, int l, LAS unsigned char* lds, int G) {
    const int tid = my_tid(), lane = tid & 63, wave = tid >> 6;
    LAS float* scr = (LAS float*)(lds + wave * 8448);
    const int gw = blockIdx.x * 8 + wave, NGW = G * 8;
#pragma unroll 1
    for (int j = 0; j < 15; ++j) {
        ConvJob q; get_job(a, l, j, q);
        const int items = (q.K / 64) * (q.N / 32);
#pragma unroll 1
        for (int it = gw; it < items; it += NGW) transpose_item(q.W, q.ldw, q.K, q.N, q.WT, q.map, scr, it, lane);
    }
    { const float* p = a.in[1] + (size_t)l * T * PLE; bf16_t* pb = (bf16_t*)(a.ws + WS_PB);
#pragma unroll 1
      for (size_t i = ((size_t)blockIdx.x * 512 + tid) * 8; i < (size_t)T * PLE; i += (size_t)G * 512 * 8) {
          const f32x4 v0 = *(const f32x4*)(p + i), v1 = *(const f32x4*)(p + i + 4);
          u32x4 w; w.x = pk2(v0[0], v0[1]); w.y = pk2(v0[2], v0[3]); w.z = pk2(v1[0], v1[1]); w.w = pk2(v1[2], v1[3]); *(u32x4*)(pb + i) = w; } }
    if (blockIdx.x < 64) { const float* w1 = a.in[10] + (size_t)l * 2 * 2048 * 256;
        const int fc = blockIdx.x, n = tid >> 8, h = tid & 255; const float* pos = a.in[9] + (size_t)l * 2 * 2048 + n * 2048 + fc * 32; const float* w = w1 + (size_t)n * 2048 * 256 + (size_t)(fc * 32) * 256 + h;
        float s = 0.f;
#pragma unroll 8
        for (int f = 0; f < 32; ++f) s += pos[f] * w[(size_t)f * 256];
        ((float*)(a.ws + WS_CBP))[fc * 512 + tid] = s; }
}

__device__ __forceinline__ void ln_phase(const float* src, const float* gam, const float* bet, float* dst, bf16_t* dstb, int G) {
    const int tid_ = my_tid(), lane = tid_ & 63, wave = tid_ >> 6;
    f32x4 gv[4], bv[4];
#pragma unroll
    for (int j = 0; j < 4; ++j) { gv[j] = *(const f32x4*)(gam + 4 * lane + 256 * j); bv[j] = *(const f32x4*)(bet + 4 * lane + 256 * j); }
    for (int row = blockIdx.x * 8 + wave; row < T; row += G * 8) {
        const float* xr = src + (size_t)row * DM + 4 * lane; f32x4 v[4]; float s = 0.f;
#pragma unroll
        for (int j = 0; j < 4; ++j) { v[j] = *(const f32x4*)(xr + 256 * j); s += (v[j][0] + v[j][1]) + (v[j][2] + v[j][3]); }
        const float mean = wave_sum(s) * (1.f / DM); float s2 = 0.f;
#pragma unroll
        for (int j = 0; j < 4; ++j) { v[j] = v[j] - mean; s2 += (v[j][0] * v[j][0] + v[j][1] * v[j][1]) + (v[j][2] * v[j][2] + v[j][3] * v[j][3]); }
        const float rstd = 1.0f / sqrtf(wave_sum(s2) * (1.f / DM) + 1e-5f);
#pragma unroll
        for (int j = 0; j < 4; ++j) { const f32x4 o = v[j] * rstd * gv[j] + bv[j]; *(f32x4*)(dst + (size_t)row * DM + 4 * lane + 256 * j) = o;
            u32x2 w; w.x = pk2(o[0], o[1]); w.y = pk2(o[2], o[3]); *(u32x2*)(dstb + (size_t)row * DM + 4 * lane + 256 * j) = w; }
    }
}

constexpr int AT_KB0 = 0, AT_VB0 = 17408, AT_BUF = 35840, AT_X = 71680, AT_MISC = 137216;
template <int DV> struct FlashSt { f32x16 o[DV / 32]; float m, l; };
template <int KW, int DV> struct StageRegs { u32x4 k[KW / 64]; u32x4 v[DV / 64]; };

template <int KW, int DV>
__device__ __forceinline__ void stage_load(StageRegs<KW, DV>& r, const bf16_t* kp, size_t ldk, const bf16_t* vp, size_t ldv, int tid) {
#pragma unroll
    for (int i = 0; i < KW / 64; ++i) { const int idx = tid + i * 512, key = idx / (KW / 8), ch = idx % (KW / 8); r.k[i] = *(const u32x4*)(kp + (size_t)key * ldk + ch * 8); }
#pragma unroll
    for (int i = 0; i < DV / 64; ++i) { const int idx = tid + i * 512, d = idx >> 3, kc = idx & 7; r.v[i] = *(const u32x4*)(vp + (size_t)d * ldv + kc * 8); }
}
template <int KW, int DV>
__device__ __forceinline__ void stage_store(const StageRegs<KW, DV>& r, LAS unsigned char* kb, LAS unsigned char* vb, int tid) {
    constexpr int KSTR = KW * 2 + 16, VSTR = 144;
#pragma unroll
    for (int i = 0; i < KW / 64; ++i) { const int idx = tid + i * 512, key = idx / (KW / 8), ch = idx % (KW / 8); *(LAS u32x4*)(kb + key * KSTR + ch * 16) = r.k[i]; }
#pragma unroll
    for (int i = 0; i < DV / 64; ++i) { const int idx = tid + i * 512, d = idx >> 3, kc = idx & 7; LAS unsigned char* p = vb + d * VSTR + (kc >> 1) * 32 + (kc & 1) * 8;
        *(LAS u32x2*)(p) = (u32x2){r.v[i].x, r.v[i].y}; *(LAS u32x2*)(p + 16) = (u32x2){r.v[i].z, r.v[i].w}; }
}
__device__ __forceinline__ bf16x8 pack8(const f32x16& s, int o) {
    u32x4 w; w.x = pk2(s[o + 0], s[o + 1]); w.y = pk2(s[o + 2], s[o + 3]); w.z = pk2(s[o + 4], s[o + 5]); w.w = pk2(s[o + 6], s[o + 7]);
    return __builtin_bit_cast(bf16x8, w);
}

template <int KW, int DV>
__device__ __forceinline__ void flash_block(FlashSt<DV>& st, const bf16x8 (&qf)[4], const LAS unsigned char* kb, const LAS unsigned char* vb, int koff, int kb0,
                                            int t, int tmin, int tmax, int W, float slope2, bool selok, bool anymask, int lane) {
    constexpr int KSTR = KW * 2 + 16, VSTR = 144;
    const int r = lane & 31, hf = lane >> 5;
    f32x16 s0 = zero16(), s1 = zero16();
    const LAS unsigned char* kp = kb + r * KSTR + koff + hf * 16;
#pragma unroll
    for (int ks = 0; ks < 4; ++ks) {
        const bf16x8 k0 = *(const LAS bf16x8*)(kp + ks * 32), k1 = *(const LAS bf16x8*)(kp + 32 * KSTR + ks * 32);
        s0 = mfma32(k0, qf[ks], s0); s1 = mfma32(k1, qf[ks], s1);
    }
    const int rel = t - kb0 - 4 * hf; const float relf = (float)rel;
    const bool edge = anymask || (kb0 + 63 > tmin) || (kb0 <= tmax - W);
    float mx = NINF;
#pragma unroll
    for (int i = 0; i < 16; ++i) {
        const int kc = (i & 3) + 8 * (i >> 2);
        float v0 = s0[i] - slope2 * (relf - (float)kc), v1 = s1[i] - slope2 * (relf - (float)(kc + 32));
        if (edge) { if (!(selok && kc <= rel && kc > rel - W)) v0 = NINF; if (!(selok && kc + 32 <= rel && kc + 32 > rel - W)) v1 = NINF; }
        s0[i] = v0; s1[i] = v1; mx = fmaxf(mx, fmaxf(v0, v1));
    }
    mx = fmaxf(mx, __shfl_xor(mx, 32));
    const float mnew = fmaxf(st.m, mx), msafe = (mnew == NINF) ? 0.f : mnew;
    const float alpha = fexp2(st.m - msafe);
    float ls = 0.f;
#pragma unroll
    for (int i = 0; i < 16; ++i) { s0[i] = fexp2(s0[i] - msafe); s1[i] = fexp2(s1[i] - msafe); ls += s0[i] + s1[i]; }
    st.l = st.l * alpha + ls; st.m = mnew;
#pragma unroll
    for (int db = 0; db < DV / 32; ++db) st.o[db] = st.o[db] * alpha;
    bf16x8 p[4]; p[0] = pack8(s0, 0); p[1] = pack8(s0, 8); p[2] = pack8(s1, 0); p[3] = pack8(s1, 8);
    const LAS unsigned char* vp = vb + r * VSTR + hf * 16;
#pragma unroll
    for (int db = 0; db < DV / 32; ++db)
#pragma unroll
        for (int g4 = 0; g4 < 4; ++g4) { const bf16x8 vf = *(const LAS bf16x8*)(vp + db * 32 * VSTR + g4 * 32); st.o[db] = mfma32(vf, p[g4], st.o[db]); }
}

template <int KW, int DV>
__device__ __forceinline__ void flash_run(LAS unsigned char* lds, FlashSt<DV>& st, const bf16x8 (&qf)[4], const bf16_t* kbase, size_t ldk, const bf16_t* vbase, size_t ldv,
                                          unsigned bits, unsigned selmask, bool use_sel, int t, int tmin, int tmax, int W, float slope2, int koff) {
    const int tid = my_tid(), lane = tid & 63;
    unsigned rem = bits;
    if (!rem) return;
    StageRegs<KW, DV> sr;
    int j = __builtin_ctz(rem); rem &= rem - 1;
    stage_load<KW, DV>(sr, kbase + (size_t)j * 64 * ldk, ldk, vbase + j * 64, ldv, tid);
    stage_store<KW, DV>(sr, lds + AT_KB0, lds + AT_VB0, tid);
    __syncthreads();
    int buf = 0;
    for (;;) {
        const int jn = rem ? __builtin_ctz(rem) : -1;
        if (jn >= 0) stage_load<KW, DV>(sr, kbase + (size_t)jn * 64 * ldk, ldk, vbase + jn * 64, ldv, tid);
        const int kb0 = j * 64;
        const bool skip = (kb0 > tmax) || (kb0 + 63 <= tmin - W);
        if (!skip) {
            const bool selok = use_sel ? ((selmask >> j) & 1u) : true;
            flash_block<KW, DV>(st, qf, lds + AT_KB0 + buf * AT_BUF, lds + AT_VB0 + buf * AT_BUF, koff, kb0, t, tmin, tmax, W, slope2, selok, use_sel, lane);
        }
        if (jn < 0) break;
        stage_store<KW, DV>(sr, lds + AT_KB0 + (buf ^ 1) * AT_BUF, lds + AT_VB0 + (buf ^ 1) * AT_BUF, tid);
        __syncthreads();
        buf ^= 1; j = jn; rem &= rem - 1;
    }
    __syncthreads();
}
__device__ __forceinline__ void load_q(bf16x8 (&qf)[4], const bf16_t* qrow, int hf) {
#pragma unroll
    for (int ks = 0; ks < 4; ++ks) qf[ks] = *(const bf16x8*)(qrow + ks * 16 + hf * 8);
}
template <int DV> __device__ __forceinline__ void flash_init(FlashSt<DV>& st) {
#pragma unroll
    for (int db = 0; db < DV / 32; ++db)
#pragma unroll
        for (int i = 0; i < 16; ++i) st.o[db][i] = 0.f;
    st.m = NINF; st.l = 0.f;
}
__device__ __forceinline__ unsigned range_bits(int lo, int hi) {
    const unsigned hi_m = (hi >= 31) ? 0xffffffffu : ((1u << (hi + 1)) - 1u); return hi_m & ~((1u << lo) - 1u);
}
__device__ __forceinline__ void store_o64(const f32x16 (&o)[2], bf16_t* orow, int hf) {
#pragma unroll
    for (int db = 0; db < 2; ++db)
#pragma unroll
        for (int q4 = 0; q4 < 4; ++q4) { u32x2 w; w.x = pk2(o[db][4 * q4], o[db][4 * q4 + 1]); w.y = pk2(o[db][4 * q4 + 2], o[db][4 * q4 + 3]);
            *(u32x2*)(orow + db * 32 + 8 * q4 + 4 * hf) = w; }
}

__device__ __forceinline__ void diff_item(const Args& a, int l, LAS unsigned char* lds, int b, int h, int qi) {
    const int tid = my_tid(), lane = tid & 63, wave = tid >> 6, mp = wave >> 2, wq = wave & 3, r = lane & 31, hf = lane >> 5;
    const bf16_t* qkv = (const bf16_t*)(a.ws + WS_A); const bf16_t* vt = (const bf16_t*)(a.ws + WS_VT); bf16_t* O = (bf16_t*)(a.ws + WS_B);
    const int q0 = qi * 128, tmin = q0 + wq * 32, tmax = tmin + 31, t = tmin + r;
    const float slope2 = fexp2(-2.0f * (float)(h + 1)) * LOG2E;
    const float lambda_init = 0.8f - 0.6f * __expf(-0.3f * (float)l);
    const float* lam = a.in[7] + l * 256;
    const float lam_full = __expf(wave_sum(lam[lane] * lam[64 + lane])) - __expf(wave_sum(lam[128 + lane] * lam[192 + lane])) + lambda_init;
    bf16x8 qf[4]; load_q(qf, qkv + (size_t)(b * SEQ + t) * LDQ + QA + h * 128 + mp * 64, hf);
    FlashSt<128> st; flash_init<128>(st);
    flash_run<128, 128>(lds, st, qf, qkv + (size_t)b * SEQ * LDQ + KA + h * 128, LDQ, vt + (size_t)(VA + h * 128) * T + (size_t)b * SEQ, T,
                        range_bits(0, 2 * qi + 1), 0u, false, t, tmin, tmax, 1 << 28, slope2, mp * 128);
    const float lt = st.l + __shfl_xor(st.l, 32); const float inv = 1.0f / lt;
    LAS float* xb = (LAS float*)(lds + AT_X) + wq * 4096 + lane;
    if (mp == 1) {
        const float f = inv * lam_full;
#pragma unroll
        for (int db = 0; db < 4; ++db)
#pragma unroll
            for (int i = 0; i < 16; ++i) xb[(db * 16 + i) * 64] = st.o[db][i] * f;
    }
    __syncthreads();
    if (mp == 0) {
        float ss = 0.f;
#pragma unroll
        for (int db = 0; db < 4; ++db)
#pragma unroll
            for (int i = 0; i < 16; ++i) { const float v = st.o[db][i] * inv - xb[(db * 16 + i) * 64]; st.o[db][i] = v; ss += v * v; }
        ss += __shfl_xor(ss, 32);
        const float rs = (DBG_ZERO & 1) ? 0.f : (1.0f / sqrtf(ss * (1.0f / 128.0f) + 1e-5f)) * (1.0f - lambda_init);
        const float* sg = a.in[8] + l * 128; bf16_t* orow = O + (size_t)(b * SEQ + t) * 1536 + h * 128;
#pragma unroll
        for (int db = 0; db < 4; ++db)
#pragma unroll
            for (int q4 = 0; q4 < 4; ++q4) { const int d = db * 32 + 8 * q4 + 4 * hf; const f32x4 gg = *(const f32x4*)(sg + d);
                u32x2 w; w.x = pk2(st.o[db][4 * q4] * rs * gg[0], st.o[db][4 * q4 + 1] * rs * gg[1]); w.y = pk2(st.o[db][4 * q4 + 2] * rs * gg[2], st.o[db][4 * q4 + 3] * rs * gg[3]);
                *(u32x2*)(orow + d) = w; }
    }
    __syncthreads();
}

__device__ __forceinline__ void swa_item(const Args& a, int l, LAS unsigned char* lds, int b, int g, int tb) {
    const int tid = my_tid(), lane = tid & 63, wave = tid >> 6, hd = wave & 3, th = wave >> 2, r = lane & 31, hf = lane >> 5;
    const bf16_t* qkv = (const bf16_t*)(a.ws + WS_A); const bf16_t* vt = (const bf16_t*)(a.ws + WS_VT); bf16_t* O = (bf16_t*)(a.ws + WS_B);
    const int head = g * 4 + hd, tmin = tb * 64 + th * 32, tmax = tmin + 31, t = tmin + r;
    const float slope2 = fexp2(-(float)(head + 1)) * LOG2E;
    bf16x8 qf[4]; load_q(qf, qkv + (size_t)(b * SEQ + t) * LDQ + QC + head * 64, hf);
    FlashSt<64> st; flash_init<64>(st);
    flash_run<64, 64>(lds, st, qf, qkv + (size_t)b * SEQ * LDQ + KCC + g * 64, LDQ, vt + (size_t)(VC + g * 64) * T + (size_t)b * SEQ, T,
                      range_bits(tb >= 2 ? tb - 2 : 0, tb), 0u, false, t, tmin, tmax, 128, slope2, 0);
    const float sink = a.in[12][l * 8 + head];
    const float lt = st.l + __shfl_xor(st.l, 32) + ((DBG_ZERO & 8) ? 0.f : fexp2(sink * LOG2E - st.m)); const float inv = 1.0f / lt;
    st.o[0] = st.o[0] * ((DBG_ZERO & 4) ? 0.f : inv); st.o[1] = st.o[1] * ((DBG_ZERO & 4) ? 0.f : inv);
    const int tp = (t & 127) * 16 + (t >> 7);
    store_o64(st.o, O + (size_t)(b * SEQ + tp) * 1536 + 1024 + head * 64, hf);
}

__device__ __forceinline__ void nsa_item(const Args& a, LAS unsigned char* lds, int b, int g, int tb) {
    const int tid = my_tid(), lane = tid & 63, wave = tid >> 6, hd = wave & 3, th = wave >> 2, r = lane & 31, hf = lane >> 5;
    const bf16_t* qkv = (const bf16_t*)(a.ws + WS_A); const bf16_t* vt = (const bf16_t*)(a.ws + WS_VT); bf16_t* O = (bf16_t*)(a.ws + WS_B);
    const bf16_t* KCb = (const bf16_t*)(a.ws + WS_KC) + (size_t)(b * 2 + g) * 128 * 64; const bf16_t* VCb = (const bf16_t*)(a.ws + WS_VCT) + (size_t)(b * 2 + g) * 64 * 128;
    const int head = g * 4 + hd, tl = th * 32 + r, tmin = tb * 64 + th * 32, tmax = tmin + 31, t = tmin + r;
    const float slope2 = fexp2(-(float)(head + 1)) * LOG2E;
    const bf16_t* trow = qkv + (size_t)(b * SEQ + t) * LDQ;
    bf16x8 qf[4]; load_q(qf, trow + QB + head * 64, hf);
    const float g0 = sigmoidf_(bf2f(trow[BG + head])), g1 = sigmoidf_(bf2f(trow[BG + 8 + head])), g2 = sigmoidf_(bf2f(trow[BG + 16 + head]));
    f32x16 out[2];
    const int ncb = (tb >= 16) ? 2 : 1;
    f32x16 sc[4];
#pragma unroll
    for (int sb = 0; sb < 4; ++sb) sc[sb] = zero16();
#pragma unroll
    for (int cb = 0; cb < 2; ++cb) if (cb < ncb) {
        const bf16_t* kp = KCb + (size_t)(cb * 64 + r) * 64 + hf * 8;
#pragma unroll
        for (int ks = 0; ks < 4; ++ks) { const bf16x8 k0 = *(const bf16x8*)(kp + ks * 16), k1 = *(const bf16x8*)(kp + 32 * 64 + ks * 16);
            sc[2 * cb] = mfma32(k0, qf[ks], sc[2 * cb]); sc[2 * cb + 1] = mfma32(k1, qf[ks], sc[2 * cb + 1]); }
    }
    float mx = NINF;
#pragma unroll
    for (int sb = 0; sb < 4; ++sb)
#pragma unroll
        for (int i = 0; i < 16; ++i) { const int c = sb * 32 + (i & 3) + 8 * (i >> 2) + 4 * hf; const int dist = t - 16 * c - 31;
            const float v = (dist >= 0 && sb < 2 * ncb) ? sc[sb][i] - slope2 * (float)dist : NINF; sc[sb][i] = v; mx = fmaxf(mx, v); }
    mx = fmaxf(mx, __shfl_xor(mx, 32));
    const float msafe = (mx == NINF) ? 0.f : mx;
    float ls = 0.f;
#pragma unroll
    for (int sb = 0; sb < 4; ++sb)
#pragma unroll
        for (int i = 0; i < 16; ++i) { const float p = fexp2(sc[sb][i] - msafe); sc[sb][i] = p; ls += p; }
    ls += __shfl_xor(ls, 32);
    const float invl = ls > 0.f ? 1.0f / ls : 0.f;
#pragma unroll
    for (int sb = 0; sb < 4; ++sb) sc[sb] = sc[sb] * invl;
    {
        LAS float* sl = (LAS float*)(lds + AT_X) + (hd * 64 + tl) * 32;
        float xprev = 0.f;
#pragma unroll
        for (int sb = 0; sb < 4; ++sb)
#pragma unroll
            for (int q4 = 0; q4 < 4; ++q4) {
                const float h3 = 0.5f * sc[sb][4 * q4 + 3];
                const float mainv = sc[sb][4 * q4] + sc[sb][4 * q4 + 1] + sc[sb][4 * q4 + 2] + h3;
                const float x = __shfl_xor(h3, 32);
                sl[sb * 8 + 2 * q4 + hf] = mainv + (hf ? x : xprev);
                xprev = x;
            }
    }
    out[0] = zero16(); out[1] = zero16();
#pragma unroll
    for (int cb = 0; cb < 2; ++cb) if (cb < ncb) {
        bf16x8 p[4]; p[0] = pack8(sc[2 * cb], 0); p[1] = pack8(sc[2 * cb], 8); p[2] = pack8(sc[2 * cb + 1], 0); p[3] = pack8(sc[2 * cb + 1], 8);
        const bf16_t* vp = VCb + (size_t)r * 128 + cb * 64 + hf * 4;
#pragma unroll
        for (int db = 0; db < 2; ++db)
#pragma unroll
            for (int g4 = 0; g4 < 4; ++g4) {
                const u32x2 lo = *(const u32x2*)(vp + db * 32 * 128 + g4 * 16), hi = *(const u32x2*)(vp + db * 32 * 128 + g4 * 16 + 8);
                const u32x4 w = (u32x4){lo.x, lo.y, hi.x, hi.y};
                out[db] = mfma32(__builtin_bit_cast(bf16x8, w), p[g4], out[db]); }
    }
    out[0] = out[0] * g0; out[1] = out[1] * g0;

    __syncthreads();
    LAS unsigned* selm = (LAS unsigned*)(lds + AT_MISC + 64);
    {
        const LAS float* sl = (const LAS float*)(lds + AT_X);
#pragma unroll 1
        for (int it = 0; it < 4; ++it) {
            const int tok = it * 16 + wave * 2 + hf, j = r;
            float s = ((sl[(0 * 64 + tok) * 32 + j] + sl[(1 * 64 + tok) * 32 + j]) + sl[(2 * 64 + tok) * 32 + j]) + sl[(3 * 64 + tok) * 32 + j];
            if (j == 0 || j == tb || j == tb - 1) s = 1e4f;
            if (j > tb) s = -1.0f;
            int rank = 0;
#pragma unroll
            for (int jj = 0; jj < 32; ++jj) { const float o = __shfl(s, (lane & 32) | jj); rank += (o > s || (o == s && jj < j)) ? 1 : 0; }
            const unsigned long long bal = __ballot(rank < 16);
            if (r == 0) selm[tok] = hf ? (unsigned)(bal >> 32) : (unsigned)bal;
        }
    }
    __syncthreads();
    if (hd == 0 && hf == 0) ((unsigned*)(a.ws + WS_SEL))[(size_t)(b * 2 + g) * SEQ + t] = selm[tl];
    {
        FlashSt<64> st; flash_init<64>(st);
        flash_run<64, 64>(lds, st, qf, qkv + (size_t)b * SEQ * LDQ + KWC + g * 64, LDQ, vt + (size_t)(VW + g * 64) * T + (size_t)b * SEQ, T,
                          range_bits(tb >= 8 ? tb - 8 : 0, tb), 0u, false, t, tmin, tmax, 512, slope2, 0);
        const float lt = st.l + __shfl_xor(st.l, 32); const float f = 1.0f / lt;
        st.o[0] = st.o[0] * f; st.o[1] = st.o[1] * f;
        const int tp = (t & 127) * 16 + (t >> 7);
        store_o64(st.o, (bf16_t*)(a.ws + WS_WIN) + (size_t)(b * SEQ + tp) * 512 + head * 64, hf);
    }
    store_o64(out, O + (size_t)(b * SEQ + t) * 1536 + 512 + head * 64, hf);
}

__device__ __forceinline__ void nsa_item_b(const Args& a, LAS unsigned char* lds, int b, int g, int tb) {
    const int tid = my_tid(), lane = tid & 63, wave = tid >> 6, hd = wave & 3, th = wave >> 2, r = lane & 31, hf = lane >> 5;
    const bf16_t* qkv = (const bf16_t*)(a.ws + WS_A); const bf16_t* vt = (const bf16_t*)(a.ws + WS_VT); bf16_t* O = (bf16_t*)(a.ws + WS_B);
    const unsigned* sel = (const unsigned*)(a.ws + WS_SEL) + (size_t)(b * 2 + g) * SEQ + tb * 64;
    const int head = g * 4 + hd, tl = th * 32 + r, tmin = tb * 64 + th * 32, tmax = tmin + 31, t = tmin + r;
    const float slope2 = fexp2(-(float)(head + 1)) * LOG2E;
    bf16x8 qf[4]; load_q(qf, qkv + (size_t)(b * SEQ + t) * LDQ + QB + head * 64, hf);
    const unsigned selmask = sel[tl];
    unsigned um = sel[lane];
#pragma unroll
    for (int o = 1; o < 64; o <<= 1) um |= __shfl_xor(um, o);
    um = __builtin_amdgcn_readfirstlane(um) & range_bits(0, tb);
    FlashSt<64> st; flash_init<64>(st);
    flash_run<64, 64>(lds, st, qf, qkv + (size_t)b * SEQ * LDQ + KS + g * 64, LDQ, vt + (size_t)(VS + g * 64) * T + (size_t)b * SEQ, T,
                      um, selmask, true, t, tmin, tmax, 1 << 28, slope2, 0);
    const float lt = st.l + __shfl_xor(st.l, 32); const float f = lt > 0.f ? 1.0f / lt : 0.f;
    const int tp = (t & 31) * 64 + (t >> 5);
    const size_t rowp = (size_t)(b * SEQ + tp);
    const bf16_t* trow = qkv + rowp * LDQ;
    const float g1 = sigmoidf_(bf2f(trow[BG + 8 + head])) * f, g2 = sigmoidf_(bf2f(trow[BG + 16 + head]));
    bf16_t* orow = O + rowp * 1536 + 512 + head * 64; const bf16_t* wrow = (const bf16_t*)(a.ws + WS_WIN) + rowp * 512 + head * 64;
#pragma unroll
    for (int db = 0; db < 2; ++db)
#pragma unroll
        for (int q4 = 0; q4 < 4; ++q4) { const int d = db * 32 + 8 * q4 + 4 * hf;
            const u32x2 cw = *(const u32x2*)(orow + d), ww = *(const u32x2*)(wrow + d);
            const float v0 = bflo(cw.x) + g1 * st.o[db][4 * q4] + g2 * bflo(ww.x), v1 = bfhi(cw.x) + g1 * st.o[db][4 * q4 + 1] + g2 * bfhi(ww.x);
            const float v2 = bflo(cw.y) + g1 * st.o[db][4 * q4 + 2] + g2 * bflo(ww.y), v3 = bfhi(cw.y) + g1 * st.o[db][4 * q4 + 3] + g2 * bfhi(ww.y);
            u32x2 w; w.x = pk2(v0, v1); w.y = pk2(v2, v3); *(u32x2*)(orow + d) = w; }
}

__device__ __forceinline__ void attn_phase(const Args& a, int l, LAS unsigned char* lds, int pass) {
    unsigned* ctr = (unsigned*)(a.ws + WS_CTL) + 64 * (l + 1) + 32 * pass;
    LAS unsigned* qslot = (LAS unsigned*)(lds + AT_MISC);
    const unsigned nitems = pass ? 1024u : 3072u;
    for (;;) {
        if (my_tid() == 0) *qslot = atomicAdd(ctr, 1u);
        __syncthreads();
        const unsigned q = *qslot;
        __syncthreads();
        if (q >= nitems) break;
        if (pass) { nsa_item_b(a, lds, (q & 31) >> 1, q & 1, 31 - (q >> 5)); continue; }
        if (q < 2048u) {
            const int s = q >> 6, rr = q & 63;
            if (rr < 32) nsa_item(a, lds, rr >> 1, rr & 1, 31 - s);
            else { const int bh = (s & 1) * 32 + (rr - 32); diff_item(a, l, lds, bh >> 2, bh & 3, 15 - (s >> 1)); }
        } else { const int x = q - 2048; swa_item(a, l, lds, x >> 6, (x >> 5) & 1, x & 31); }
    }
}

__device__ __forceinline__ void cmp_gemm2(const Args& a) {
    const int c = blockIdx.x; if (c >= 32) return;
    const int tid_ = my_tid(), n = c >> 4, rt = c & 15, lane = tid_ & 63, wave = tid_ >> 6, r = lane & 31, hf = lane >> 5;
    const bf16_t* hid = (const bf16_t*)(a.ws + WS_HID) + ((size_t)n * 4096 + rt * 256 + wave * 32) * 256;
    const bf16_t* w2 = (const bf16_t*)(a.ws + WS_W) + W_C2 + n * 64 * 256;
    f32x16 acc[2]; acc[0] = zero16(); acc[1] = zero16();
#pragma unroll 4
    for (int ks = 0; ks < 16; ++ks) {
        const bf16x8 hf8 = *(const bf16x8*)(hid + (size_t)r * 256 + ks * 16 + hf * 8);
        const bf16x8 w0 = *(const bf16x8*)(w2 + (size_t)r * 256 + ks * 16 + hf * 8), w1 = *(const bf16x8*)(w2 + (size_t)(32 + r) * 256 + ks * 16 + hf * 8);
        acc[0] = mfma32(hf8, w0, acc[0]); acc[1] = mfma32(hf8, w1, acc[1]);
    }
    const int R0 = rt * 256 + wave * 32, gg = R0 >> 11, bb = (R0 >> 7) & 15, cc0 = R0 & 127;
    if (n == 0) {
        bf16_t* kp = (bf16_t*)(a.ws + WS_KC) + ((size_t)(bb * 2 + gg) * 128 + cc0 + 4 * hf) * 64 + r;
#pragma unroll
        for (int db = 0; db < 2; ++db)
#pragma unroll
            for (int i = 0; i < 16; ++i) kp[((i & 3) + 8 * (i >> 2)) * 64 + db * 32] = (bf16_t)(pk2(acc[db][i], 0.f) & 0xffffu);
    } else {
#pragma unroll
        for (int db = 0; db < 2; ++db) {
            bf16_t* vp = (bf16_t*)(a.ws + WS_VCT) + ((size_t)(bb * 2 + gg) * 64 + db * 32 + r) * 128 + cc0 + 4 * hf;
#pragma unroll
            for (int i = 0; i < 16; ++i) vp[(i & 3) + 8 * (i >> 2)] = (bf16_t)(pk2(acc[db][i], 0.f) & 0xffffu);
        }
    }
}


constexpr int NPH = 31;
__device__ __forceinline__ void gd_build(GemmDesc& g, const Args& a, int l, int p, int gi) {
    unsigned char* ws = a.ws;
    bf16_t* wb = (bf16_t*)(ws + WS_W); bf16_t* xb = (bf16_t*)(ws + WS_XB);
    bf16_t* RA = (bf16_t*)(ws + WS_A); bf16_t* hb = (bf16_t*)(ws + WS_VT); float* V = (float*)(ws + WS_B);
    const size_t T1K = (size_t)256 * 1024 * 2;
    g.A = (const char*)xb; g.Bt = nullptr; g.lda = 1024; g.ldb = 1024; g.ksA = 128; g.nt = 16; g.nM = 128; g.nN = 4; g.nz = 1; g.cmp = 0; g.perm = 1; g.mode = EP_BF16;
    g.a_tile = T1K; g.b_tile = T1K; g.a_z = 0; g.b_z = 0; g.f0 = V; g.xres = a.out; g.o16 = RA; g.bias = nullptr; g.ldc = 1024; g.scale = 1.f;
    switch (p) {
    case 0: case 11: g.Bt = (const char*)(wb + (p == 0 ? W_F1A : W_F2A)); g.nN = 22; g.mode = EP_SWIGLU; g.ldc = DFF; break;
    case 1: case 12: g.A = (const char*)RA; g.lda = DFF; g.Bt = (const char*)(wb + (p == 1 ? W_F1B : W_F2B)); g.ldb = DFF; g.nt = 44;
        g.a_tile = (size_t)256 * DFF * 2; g.b_tile = (size_t)256 * DFF * 2; g.mode = EP_RES; g.perm = 0; g.xres = (l == 0 && p == 1) ? a.in[0] : a.out; g.scale = 0.5f; g.o16 = (p == 12) ? hb : nullptr; break;
    case 3:
        if (gi == 0) { g.Bt = (const char*)(wb + W_TOK); g.nN = 11; g.ldc = LDQ; }
        else { g.A = (const char*)(wb + W_VT); g.Bt = (const char*)xb; g.nM = 4; g.nN = 128; g.o16 = (bf16_t*)(ws + WS_VT); g.ldc = T; }
        break;
    case 4: g.cmp = 1; g.A = (const char*)(RA + KVC); g.lda = 16 * LDQ; g.ksA = LDQ * 2; g.nt = 32; g.a_tile = (size_t)256 * 16 * LDQ * 2;
        g.Bt = (const char*)(wb + W_C1); g.ldb = 2048; g.b_z = (size_t)256 * 2048 * 2; g.mode = EP_GELU; g.o16 = (bf16_t*)(ws + WS_HID); g.ldc = 256; g.bias = (const float*)(ws + WS_CB); break;
    case 7: g.Bt = (const char*)(wb + W_MG); g.nN = 12; g.mode = EP_SIG16; g.ldc = 3072; break;
    case 8: g.A = (const char*)(ws + WS_B); g.lda = 1536; g.Bt = (const char*)(wb + W_BR); g.ldb = 1536; g.nt = 8; g.nz = 3; g.a_tile = (size_t)256 * 1536 * 2; g.b_tile = (size_t)256 * 1536 * 2;
        g.a_z = 1024; g.b_z = 1024; g.mode = EP_BRANCH; g.ldc = 3072; break;
    case 9: g.A = (const char*)RA; g.lda = 3072; g.Bt = (const char*)(wb + W_O); g.a_tile = (size_t)256 * 3072 * 2; g.mode = EP_RES; g.perm = 0; g.o16 = nullptr; break;
    default:
        if (gi == 0) { g.A = (const char*)(ws + WS_PB); g.lda = 256; g.Bt = (const char*)(wb + W_PI); g.ldb = 256; g.nt = 4; g.a_tile = (size_t)256 * 256 * 2; g.b_tile = (size_t)256 * 256 * 2; g.mode = EP_PE16; g.perm = 0; }
        else { g.A = (const char*)hb; g.Bt = (const char*)(wb + W_PG); g.mode = EP_PLEGATE; g.perm = 0; }
        break;
    }
}

__global__ void __launch_bounds__(512) fwd_kernel(Args a_kernarg) {
    extern __shared__ __attribute__((aligned(16))) unsigned char lds_raw[];
    LAS unsigned char* lds = (LAS unsigned char*)lds_raw;
    const int G = gridDim.x, c = blockIdx.x;
    const int ph_lo = a_kernarg.ph_lo, ph_hi = a_kernarg.ph_hi;
#pragma unroll 1
    for (int ph = ph_lo; ph < ph_hi; ++ph) {
        if (ph > ph_lo) {
            __builtin_amdgcn_fence(__ATOMIC_RELEASE, "agent");
            cg::this_grid().sync();
            __builtin_amdgcn_fence(__ATOMIC_ACQUIRE, "agent");
        }
        const Args a = load_args();
        const int l = ph == 0 ? 0 : (ph - 1) / 15, p = ph == 0 ? -1 : (ph - 1) % 15;
        if (ph == 0) {
            const float* x = a.in[0]; bf16_t* xb = (bf16_t*)(a.ws + WS_XB); const int tid = my_tid();
#pragma unroll 1
            for (size_t i = ((size_t)c * 512 + tid) * 8; i < (size_t)T * DM; i += (size_t)G * 512 * 8) {
                const f32x4 v0 = *(const f32x4*)(x + i), v1 = *(const f32x4*)(x + i + 4);
                u32x4 w; w.x = pk2(v0[0], v0[1]); w.y = pk2(v0[2], v0[3]); w.z = pk2(v1[0], v1[1]); w.w = pk2(v1[2], v1[3]); *(u32x4*)(xb + i) = w; }
        }
        if (p == 2 || p == 10 || p == 14) {
            if (p == 2 && c == 0) { float s = 0.f; const int tid = my_tid(); const float* part = (const float*)(a.ws + WS_CBP);
#pragma unroll 8
                for (int f = 0; f < 64; ++f) s += part[f * 512 + tid];
                ((float*)(a.ws + WS_CB))[tid] = s; }
            const int k = (p == 2) ? 0 : (p == 10 ? 1 : 2);
            ln_phase((const float*)(a.ws + WS_B), a.in[4] + (l * 3 + k) * DM, a.in[5] + (l * 3 + k) * DM, a.out, (bf16_t*)(a.ws + WS_XB), G);
        }
        if (ph == 0 || (p == 14 && l == 0)) convert_layer(a, ph == 0 ? 0 : 1, lds, G);
        if (p == 5 || p == 6) attn_phase(a, l, lds, p - 5);
        const int ngemm = (p == 0 || p == 1 || p == 4 || p == 7 || p == 8 || p == 9 || p == 11 || p == 12) ? 1 : ((p == 3 || p == 13) ? 2 : 0);
#pragma unroll 1
        for (int gi = 0; gi < ngemm; ++gi) gemm_phase(lds, l, p, gi, c, G);
        if (p == 4) { __threadfence(); __syncthreads(); cmp_gemm2(load_args()); }
    }
}

extern "C" void kernel_launch(void* const* d_in, const int* in_sizes, int n_in, void* d_out, int out_size, void* d_ws, size_t ws_size, hipStream_t stream) {
    static int grid = 0;
    if (grid == 0) {
        int dev = 0, cus = 0;
        hipGetDevice(&dev); hipDeviceGetAttribute(&cus, hipDeviceAttributeMultiprocessorCount, dev);
        if (hipFuncSetAttribute((const void*)fwd_kernel, hipFuncAttributeMaxDynamicSharedMemorySize, LDS_BYTES) != hipSuccess) fprintf(stderr, "kernel_launch: hipFuncSetAttribute failed\n");
        int per_cu = 0; hipOccupancyMaxActiveBlocksPerMultiprocessor(&per_cu, (const void*)fwd_kernel, 512, LDS_BYTES); (void)hipGetLastError();
        grid = cus > 0 ? cus : 256;
        if (ws_size < WS_END) { fprintf(stderr, "kernel_launch: workspace too small: %zu < %zu\n", ws_size, (size_t)WS_END); grid = -1; }
        if (n_in != 17) { fprintf(stderr, "kernel_launch: expected 17 inputs\n"); grid = -1; }
    }
    if (grid < 0) return;
    hipMemsetAsync((char*)d_ws + WS_CTL, 0, 4096, stream);
    Args a{};
    for (int i = 0; i < 17; ++i) a.in[i] = (const float*)d_in[i];
    a.out = (float*)d_out; a.ws = (unsigned char*)d_ws;
#if N_LAUNCH_MODE == 0
    a.ph_lo = 0; a.ph_hi = NPH;
    void* args[] = {&a};
    hipError_t e = hipLaunchCooperativeKernel((const void*)fwd_kernel, dim3(grid), dim3(512), args, LDS_BYTES, stream);
    if (e != hipSuccess) fprintf(stderr, "cooperative launch failed: %s (grid %d)\n", hipGetErrorString(e), grid);
#else
    for (int ph = 0; ph < NPH; ++ph) { a.ph_lo = ph; a.ph_hi = ph + 1; hipLaunchKernelGGL(fwd_kernel, dim3(grid), dim3(512), LDS_BYTES, stream, a); }

#endif
}
```

```cpp
#include <hip/hip_runtime.h>
#include <hip/hip_cooperative_groups.h>
#include <cstdio>
#include <cstdint>
namespace cg = cooperative_groups;

#define LAS __attribute__((address_space(3)))
typedef unsigned short bf16_t;
typedef short bf16x8 __attribute__((ext_vector_type(8)));
typedef float f32x4 __attribute__((ext_vector_type(4)));
typedef float f32x16 __attribute__((ext_vector_type(16)));
typedef unsigned u32x4 __attribute__((ext_vector_type(4)));
typedef unsigned u32x2 __attribute__((ext_vector_type(2)));

#ifndef DBG_ZERO
#define DBG_ZERO 0
#endif
#ifndef STATIC_QUEUE
#define STATIC_QUEUE 0
#endif
#ifndef N_LAUNCH_MODE
#define N_LAUNCH_MODE 0
#endif

constexpr int T = 32768, DM = 1024, SEQ = 2048, NB = 16, DFF = 2816, PLE = 256;
constexpr int LDQ = 2816;
constexpr int QA = 0, KA = 512, QB = 1024, KVC = 1536, KS = 1792, KWC = 1920, QC = 2048, KCC = 2560, BG = 2688;
constexpr int VA = 0, VS = 512, VW = 640, VC = 768;
constexpr int DIN = 6680;
constexpr float LOG2E = 1.4426950408889634f;
constexpr float QSCALE = 0.125f * LOG2E;
constexpr float ALPHA = 1.4142135623730951f;
constexpr float NINF = -__builtin_inff();
constexpr int LDS_BYTES = 147456;

constexpr size_t WS_CTL = 0;
constexpr size_t WS_CB = 4096;
constexpr size_t WS_CBP = WS_CB + 2048;
constexpr size_t WS_W = WS_CBP + 64 * 512 * 4;
constexpr size_t W_F1A = 0, W_F1B = W_F1A + 5767168, W_F2A = W_F1B + 2883584, W_F2B = W_F2A + 5767168, W_TOK = W_F2B + 2883584,
                 W_VT = W_TOK + 2883584, W_MG = W_VT + 1048576, W_BR = W_MG + 3145728, W_O = W_BR + 1572864, W_PI = W_O + 1048576,
                 W_PG = W_PI + 262144, W_C1 = W_PG + 1048576, W_C2 = W_C1 + 1048576, W_END = W_C2 + 32768;
constexpr size_t WS_PB = WS_W + W_END * 2;
constexpr size_t WS_XB = WS_PB + (size_t)T * PLE * 2;
constexpr size_t WS_A = WS_XB + (size_t)T * DM * 2;
constexpr size_t WS_VT = WS_A + (size_t)T * LDQ * 2;
constexpr size_t WS_B = WS_A + (size_t)T * LDQ * 2 + (size_t)1024 * T * 2;
constexpr size_t WS_KC = WS_B + (size_t)T * DM * 4;
constexpr size_t WS_VCT = WS_KC + 524288;
constexpr size_t WS_HID = WS_VCT + 524288;
constexpr size_t WS_SEL = WS_HID + 4194304;
constexpr size_t WS_WIN = WS_B + (size_t)T * 1536 * 2;
constexpr size_t WS_END = WS_SEL + 262144;

struct Args {
    const float* in[17];
    float* out; unsigned char* ws;
    int ph_lo, ph_hi;
};

#define CAS __attribute__((address_space(4)))
__device__ __forceinline__ Args load_args() {
#if defined(__HIP_DEVICE_COMPILE__)
    const CAS Args* kp = (const CAS Args*)__builtin_amdgcn_kernarg_segment_ptr();
    asm volatile("" : "+s"(kp));
    Args r;
#pragma unroll
    for (int i = 0; i < 17; ++i) r.in[i] = kp->in[i];
    r.out = kp->out; r.ws = kp->ws; r.ph_lo = kp->ph_lo; r.ph_hi = kp->ph_hi;
    return r;
#else
    return Args{};
#endif
}
template <class X> __device__ __forceinline__ X launder_s(X v) { asm volatile("" : "+s"(v)); return v; }
__device__ __forceinline__ int my_tid() { int t = threadIdx.x; asm volatile("" : "+v"(t)); return t; }
typedef float f32x2_t __attribute__((ext_vector_type(2)));
typedef __bf16 bf16x2_t __attribute__((ext_vector_type(2)));
__device__ __forceinline__ unsigned pk2(float lo, float hi) { const f32x2_t v = {lo, hi}; return __builtin_bit_cast(unsigned, __builtin_convertvector(v, bf16x2_t)); }
__device__ __forceinline__ float bf2f(bf16_t v) { return __uint_as_float(((unsigned)v) << 16); }
__device__ __forceinline__ float bflo(unsigned w) { return __uint_as_float(w << 16); }
__device__ __forceinline__ float bfhi(unsigned w) { return __uint_as_float(w & 0xffff0000u); }
__device__ __forceinline__ float fexp2(float x) { return __builtin_amdgcn_exp2f(x); }
__device__ __forceinline__ float frcp(float x) { return __builtin_amdgcn_rcpf(x); }
__device__ __forceinline__ float sigmoidf_(float x) { return frcp(1.0f + fexp2(-x * LOG2E)); }
__device__ __forceinline__ float gelu_tanh(float x) { const float u = 1.5957691216057308f * (x + 0.044715f * x * x * x); return x * sigmoidf_(u); }
__device__ __forceinline__ f32x16 zero16() {
    f32x16 z;
#pragma unroll
    for (int i = 0; i < 16; ++i) z[i] = 0.f;
    asm volatile("" : "+v"(z));
    return z;
}
__device__ __forceinline__ f32x16 mfma32(bf16x8 a, bf16x8 b, f32x16 c) { return __builtin_amdgcn_mfma_f32_32x32x16_bf16(a, b, c, 0, 0, 0); }
__device__ __forceinline__ float wave_sum(float v) {
#pragma unroll
    for (int o = 1; o < 64; o <<= 1) v += __shfl_xor(v, o);
    return v;
}

namespace pg8 {
constexpr int BM = 256, BK = 64, HALF = 128, HTB = HALF * BK * 2, NXCD = 8, WGM = 8;
__device__ __forceinline__ int lds_byte(int r, int c) { const int st = (r >> 4) * 2 + (c >> 5), rr = r & 15, cc = c & 31, ob = rr * 64 + cc * 2; return st * 1024 + (ob ^ (((ob >> 9) & 1) << 5)); }
__device__ __forceinline__ void stage_rc(int b, int& R, int& C) { const int st = b / 1024, sb = b % 1024, swz = sb ^ (((sb >> 9) & 1) << 5); R = (st >> 1) * 16 + swz / 64; C = (st & 1) * 32 + (swz % 64) / 2; }
__device__ __forceinline__ int perm32(int rho) { const int n = rho >> 4, i = rho & 15; return 8 * (i >> 2) + 4 * n + (i & 3); }
}
enum { EP_SWIGLU = 0, EP_RES = 1, EP_BF16 = 2, EP_SIG16 = 3, EP_BRANCH = 4, EP_GELU = 5, EP_PE16 = 6, EP_PLEGATE = 7 };
struct GemmDesc {
    const char* A; const char* Bt;
    unsigned lda, ldb, ksA;
    int nt, nM, nN, nz, cmp, perm, mode;
    size_t a_tile, b_tile, a_z, b_z;
    float* f0; const float* xres; bf16_t* o16; const float* bias;
    int ldc; float scale;
};
struct Unit { int pm, pn, z; const char* a; const char* b; };

__device__ __forceinline__ bool gnext(const GemmDesc& g, int c, int G, int i, Unit& u) {
    if (g.cmp) {
        if (i != 0 || c >= 32) return false;
        const int n = c >> 4, rt = c & 15; u.pm = rt; u.pn = 0; u.z = n;
        u.a = g.A + n * 256 + (rt >> 3) * 128 + (size_t)(rt & 7) * g.a_tile; u.b = g.Bt + (size_t)n * g.b_z; return true;
    }
    int ti = i, z = 0; if (g.nz > 1) { ti = i / g.nz; z = i - ti * g.nz; }
    const int nwg = g.nM * g.nN; const long L = (long)ti * G + c; if (L >= nwg) return false;
    int wgid = (int)L; { const int q = nwg / pg8::NXCD, r = nwg % pg8::NXCD, xcd = wgid % pg8::NXCD, off = wgid / pg8::NXCD; wgid = (xcd < r ? xcd * (q + 1) : r * (q + 1) + (xcd - r) * q) + off; }
    const int nig = pg8::WGM * g.nN, gid = wgid / nig, fm = gid * pg8::WGM, gsz = (g.nM - fm) < pg8::WGM ? (g.nM - fm) : pg8::WGM;
    u.pm = fm + ((wgid % nig) % gsz); u.pn = (wgid % nig) / gsz; u.z = z;
    u.a = g.A + (size_t)u.pm * g.a_tile + (size_t)z * g.a_z; u.b = g.Bt + (size_t)u.pn * g.b_tile + (size_t)z * g.b_z; return true;
}

__device__ __forceinline__ void gemm_epilogue(const GemmDesc& g, const f32x4 (&acc)[2][2][4][2], const Unit& u, int wr, int wc, int fr, int fq) {
    const int row0 = u.pm * 256 + wr * 64 + fr;
    if (g.mode == EP_SWIGLU) {
        const int col0 = u.pn * 128 + wc * 32 + 8 * fq;
#pragma unroll
        for (int ai = 0; ai < 2; ++ai)
#pragma unroll
            for (int m = 0; m < 4; ++m) {
                float o[8];
#pragma unroll
                for (int n = 0; n < 2; ++n)
#pragma unroll
                    for (int j = 0; j < 4; ++j) { const float gt = acc[ai][0][m][n][j], up = acc[ai][1][m][n][j]; o[4 * n + j] = gt * sigmoidf_(gt) * up; }
                u32x4 w; w.x = pk2(o[0], o[1]); w.y = pk2(o[2], o[3]); w.z = pk2(o[4], o[5]); w.w = pk2(o[6], o[7]);
                *(u32x4*)(g.o16 + (size_t)(row0 + ai * 128 + m * 16) * g.ldc + col0) = w;
            }
    } else if (g.mode == EP_BF16 || g.mode == EP_SIG16 || g.mode == EP_GELU) {
        const int col0 = u.pn * 256 + wc * 32 + 8 * fq;
        bf16_t* base = g.o16; f32x4 bv[2][2];
#pragma unroll
        for (int bj = 0; bj < 2; ++bj)
#pragma unroll
            for (int n = 0; n < 2; ++n) bv[bj][n] = (f32x4){0.f, 0.f, 0.f, 0.f};
        if (g.mode == EP_GELU) {
            base += (size_t)u.z * 4096 * 256;
#pragma unroll
            for (int bj = 0; bj < 2; ++bj)
#pragma unroll
                for (int n = 0; n < 2; ++n) bv[bj][n] = *(const f32x4*)(g.bias + u.z * 256 + col0 + bj * 128 + 4 * n);
        }
#pragma unroll
        for (int ai = 0; ai < 2; ++ai)
#pragma unroll
            for (int m = 0; m < 4; ++m) {
                bf16_t* rowp = base + (size_t)(row0 + ai * 128 + m * 16) * g.ldc + col0;
#pragma unroll
                for (int bj = 0; bj < 2; ++bj) {
                    f32x4 v0 = acc[ai][bj][m][0] + bv[bj][0], v1 = acc[ai][bj][m][1] + bv[bj][1];
                    if (g.mode == EP_SIG16) {
#pragma unroll
                        for (int j = 0; j < 4; ++j) { v0[j] = sigmoidf_(v0[j]); v1[j] = sigmoidf_(v1[j]); }
                    } else if (g.mode == EP_GELU) {
#pragma unroll
                        for (int j = 0; j < 4; ++j) { v0[j] = gelu_tanh(v0[j]); v1[j] = gelu_tanh(v1[j]); }
                    }
                    u32x4 w; w.x = pk2(v0[0], v0[1]); w.y = pk2(v0[2], v0[3]); w.z = pk2(v1[0], v1[1]); w.w = pk2(v1[2], v1[3]);
                    *(u32x4*)(rowp + bj * 128) = w;
                }
            }
    } else if (g.mode == EP_BRANCH) {
        const int col0 = u.pn * 256 + wc * 32 + 8 * fq;
#pragma unroll
        for (int ai = 0; ai < 2; ++ai)
#pragma unroll
            for (int m = 0; m < 4; ++m) {
                bf16_t* rowp = g.o16 + (size_t)(row0 + ai * 128 + m * 16) * g.ldc + col0;
#pragma unroll
                for (int bj = 0; bj < 2; ++bj) {
                    const u32x4 gw = *(const u32x4*)(rowp + u.z * 1024 + bj * 128);
                    f32x4 v0 = acc[ai][bj][m][0], v1 = acc[ai][bj][m][1];
                    v0[0] *= bflo(gw.x); v0[1] *= bfhi(gw.x); v0[2] *= bflo(gw.y); v0[3] *= bfhi(gw.y);
                    v1[0] *= bflo(gw.z); v1[1] *= bfhi(gw.z); v1[2] *= bflo(gw.w); v1[3] *= bfhi(gw.w);
                    if (u.z > 0) {
                        const u32x4 pw = *(const u32x4*)(rowp + bj * 128);
                        v0[0] += bflo(pw.x); v0[1] += bfhi(pw.x); v0[2] += bflo(pw.y); v0[3] += bfhi(pw.y);
                        v1[0] += bflo(pw.z); v1[1] += bfhi(pw.z); v1[2] += bflo(pw.w); v1[3] += bfhi(pw.w);
                    }
                    u32x4 w; w.x = pk2(v0[0], v0[1]); w.y = pk2(v0[2], v0[3]); w.z = pk2(v1[0], v1[1]); w.w = pk2(v1[2], v1[3]);
                    *(u32x4*)(rowp + bj * 128) = w;
                }
            }
    } else {
        const int col0 = u.pn * 256 + wc * 32 + 4 * fq;
#pragma unroll
        for (int ai = 0; ai < 2; ++ai)
#pragma unroll
            for (int m = 0; m < 4; ++m) {
                const size_t off = (size_t)(row0 + ai * 128 + m * 16) * g.ldc + col0;
#pragma unroll
                for (int bj = 0; bj < 2; ++bj)
#pragma unroll
                    for (int n = 0; n < 2; ++n) {
                        const size_t o = off + bj * 128 + n * 16; const f32x4 a = acc[ai][bj][m][n];
                        if (g.mode == EP_RES) {
                            const f32x4 xr = *(const f32x4*)(g.xres + o); const f32x4 v = xr * ALPHA + a * g.scale;
                            *(f32x4*)(g.f0 + o) = v;
                            if (g.o16) { u32x2 w; w.x = pk2(v[0], v[1]); w.y = pk2(v[2], v[3]); *(u32x2*)(g.o16 + o) = w; }
                        } else if (g.mode == EP_PE16) {
                            u32x2 w; w.x = pk2(a[0], a[1]); w.y = pk2(a[2], a[3]); *(u32x2*)(g.o16 + o) = w;
                        } else {
                            const u32x2 pw = *(const u32x2*)(g.o16 + o); f32x4 v = *(const f32x4*)(g.f0 + o);
                            v[0] += sigmoidf_(a[0]) * bflo(pw.x); v[1] += sigmoidf_(a[1]) * bfhi(pw.x); v[2] += sigmoidf_(a[2]) * bflo(pw.y); v[3] += sigmoidf_(a[3]) * bfhi(pw.y);
                            *(f32x4*)(g.f0 + o) = v;
                        }
                    }
            }
    }
}

__device__ __forceinline__ void gd_build(GemmDesc& g, const Args& a, int l, int p, int gi);
__device__ __forceinline__ void gemm_phase(LAS unsigned char* lds, int l, int p, int gi, int c, int G) {
    using namespace pg8;
    const int tid = my_tid(), wid = __builtin_amdgcn_readfirstlane(tid >> 6), lane = tid & 63, wr = wid >> 2, wc = wid & 3, fr = lane & 15, fq = lane >> 4;
    Unit cur, nxt; int ui = 0;
    unsigned voffA[2], voffB[2]; int nt; size_t kstepA, hstepA, hstepB; const size_t kstepB = 128;
    { GemmDesc g; gd_build(g, load_args(), l, p, gi);
      if (!gnext(g, c, G, 0, cur)) return;
      nt = g.nt;
#pragma unroll
      for (int i = 0; i < 2; ++i) { int R, C; stage_rc(tid * 16 + i * 8192, R, C); const int Rb = g.perm ? ((R & ~31) + perm32(R & 31)) : R;
          voffA[i] = (unsigned)(R * g.lda + C) * 2u; voffB[i] = (unsigned)(Rb * g.ldb + C) * 2u; }
      kstepA = g.ksA; hstepA = (size_t)HALF * g.lda * 2; hstepB = (size_t)HALF * g.ldb * 2; }
    const unsigned ldsw = (unsigned)wid * 1024u;
    const int aoff = lds_byte(wr * 64 + fr, fq * 8), boff = lds_byte(wc * 32 + fr, fq * 8);
#define PG8_SA(b, h) (((b) * 2 + (h)) * HTB)
#define PG8_SB(b, h) ((4 + (b) * 2 + (h)) * HTB)
#define PG8_STAGE(bufoff, gbase, voff) do { _Pragma("unroll") for (int _i = 0; _i < 2; ++_i) \
        __builtin_amdgcn_global_load_lds((const unsigned*)((const char*)(gbase) + (voff)[_i]), (LAS unsigned*)(lds + (bufoff) + ldsw + _i * 8192), 16, 0, 0); } while (0)
#define PG8_LDA(dst, b, h) do { _Pragma("unroll") for (int m = 0; m < 4; ++m) _Pragma("unroll") for (int k = 0; k < 2; ++k) dst[m][k] = *(const LAS bf16x8*)(lds + PG8_SA(b, h) + aoff + m * 2048 + k * 1024); } while (0)
#define PG8_LDB(dst, b, h) do { _Pragma("unroll") for (int n = 0; n < 2; ++n) _Pragma("unroll") for (int k = 0; k < 2; ++k) dst[n][k] = *(const LAS bf16x8*)(lds + PG8_SB(b, h) + boff + n * 2048 + k * 1024); } while (0)
#define PG8_MMA(ai, bj, At, Bt) do { __builtin_amdgcn_s_setprio(1); _Pragma("unroll") for (int m = 0; m < 4; ++m) _Pragma("unroll") for (int n = 0; n < 2; ++n) _Pragma("unroll") for (int k = 0; k < 2; ++k) \
        acc[ai][bj][m][n] = __builtin_amdgcn_mfma_f32_16x16x32_bf16(Bt[n][k], At[m][k], acc[ai][bj][m][n], 0, 0, 0); __builtin_amdgcn_s_setprio(0); } while (0)
#define PG8_WAIT_V(n) asm volatile("s_waitcnt vmcnt(" #n ")" ::: "memory")
#define PG8_WAIT_L(n) asm volatile("s_waitcnt lgkmcnt(" #n ")" ::: "memory")
#define PG8_BAR __builtin_amdgcn_s_barrier()
#define PG8_SCHED __builtin_amdgcn_sched_barrier(0)
    f32x4 acc[2][2][4][2];
#pragma unroll
    for (int a = 0; a < 2; ++a)
#pragma unroll
        for (int b = 0; b < 2; ++b)
#pragma unroll
            for (int m = 0; m < 4; ++m)
#pragma unroll
                for (int n = 0; n < 2; ++n) acc[a][b][m][n] = (f32x4){0.f, 0.f, 0.f, 0.f};
    bf16x8 At[4][2], B0[2][2], B1[2][2];
    const char* cA = cur.a; const char* cB = cur.b;
    PG8_STAGE(PG8_SB(0, 0), cB, voffB); PG8_STAGE(PG8_SA(0, 0), cA, voffA); PG8_STAGE(PG8_SB(0, 1), cB + hstepB, voffB); PG8_STAGE(PG8_SA(0, 1), cA + hstepA, voffA);
    if (wr == 1) PG8_BAR;
    PG8_WAIT_V(4); PG8_BAR;
    PG8_STAGE(PG8_SB(1, 0), cB + kstepB, voffB); PG8_STAGE(PG8_SA(1, 0), cA + kstepA, voffA); PG8_STAGE(PG8_SB(1, 1), cB + hstepB + kstepB, voffB);
    PG8_WAIT_V(6); PG8_BAR;
    for (;;) {
        bool has_next; { GemmDesc g; gd_build(g, load_args(), launder_s(l), p, gi); has_next = gnext(g, c, G, ui + 1, nxt); }
        const char* nA = has_next ? nxt.a : cA; const char* nB = has_next ? nxt.b : cB;
        for (int t = 0; t < nt; t += 2) {
            const bool last = (t == nt - 2);
            const char* a1 = cA + (size_t)(t + 1) * kstepA;
            const char* a2 = last ? nA : cA + (size_t)(t + 2) * kstepA; const char* b2 = last ? nB : cB + (size_t)(t + 2) * kstepB;
            const char* a3 = a2 + kstepA; const char* b3 = b2 + kstepB;
            PG8_LDB(B0, 0, 0); PG8_SCHED; PG8_LDA(At, 0, 0); PG8_STAGE(PG8_SA(1, 1), a1 + hstepA, voffA);
            PG8_WAIT_L(8); PG8_BAR; PG8_WAIT_L(0); PG8_MMA(0, 0, At, B0); PG8_BAR; PG8_SCHED;
            PG8_LDB(B1, 0, 1); PG8_STAGE(PG8_SB(0, 0), b2, voffB);
            PG8_BAR; PG8_WAIT_L(0); PG8_MMA(0, 1, At, B1); PG8_BAR;
            PG8_LDA(At, 0, 1); PG8_STAGE(PG8_SA(0, 0), a2, voffA);
            PG8_BAR; PG8_WAIT_L(0); PG8_MMA(1, 0, At, B0); PG8_BAR; PG8_SCHED;
            PG8_STAGE(PG8_SB(0, 1), b2 + hstepB, voffB);
            PG8_WAIT_V(6); PG8_BAR; PG8_MMA(1, 1, At, B1); PG8_BAR;
            PG8_LDB(B0, 1, 0); PG8_SCHED; PG8_LDA(At, 1, 0); PG8_STAGE(PG8_SA(0, 1), a2 + hstepA, voffA);
            PG8_WAIT_L(8); PG8_BAR; PG8_WAIT_L(0); PG8_MMA(0, 0, At, B0); PG8_BAR; PG8_SCHED;
            PG8_LDB(B1, 1, 1); PG8_STAGE(PG8_SB(1, 0), b3, voffB);
            PG8_BAR; PG8_WAIT_L(0); PG8_MMA(0, 1, At, B1); PG8_BAR;
            PG8_LDA(At, 1, 1); PG8_STAGE(PG8_SA(1, 0), a3, voffA);
            PG8_BAR; PG8_WAIT_L(0); PG8_MMA(1, 0, At, B0); PG8_BAR; PG8_SCHED;
            PG8_STAGE(PG8_SB(1, 1), b3 + hstepB, voffB);
            PG8_WAIT_V(6); PG8_BAR; PG8_MMA(1, 1, At, B1); PG8_BAR;
        }
        { GemmDesc g; gd_build(g, load_args(), launder_s(l), p, gi); gemm_epilogue(g, acc, cur, wr, wc, fr, fq); }
        if (!has_next) break;
#pragma unroll
        for (int a = 0; a < 2; ++a)
#pragma unroll
            for (int b = 0; b < 2; ++b)
#pragma unroll
                for (int m = 0; m < 4; ++m)
#pragma unroll
                    for (int n = 0; n < 2; ++n) acc[a][b][m][n] = (f32x4){0.f, 0.f, 0.f, 0.f};
        cur = nxt; cA = nA; cB = nB; ++ui;
    }
    PG8_WAIT_V(0);
    if (wr == 0) PG8_BAR;
    PG8_BAR;
#undef PG8_SA
#undef PG8_SB
#undef PG8_STAGE
#undef PG8_LDA
#undef PG8_LDB
#undef PG8_MMA
#undef PG8_WAIT_V
#undef PG8_WAIT_L
#undef PG8_BAR
#undef PG8_SCHED
}

enum { MAP_ID = 0, MAP_FFN = 1, MAP_TOK = 2, MAP_VT = 3, MAP_MG = 4 };
__device__ __forceinline__ int map_col(int map, int n, float& sc) {
    sc = 1.0f;
    if (map == MAP_ID) return n;
    if (map == MAP_FFN) { const int pn = n >> 8, half = (n >> 7) & 1, idx = n & 127; return half * DFF + pn * 128 + idx; }
    if (map == MAP_MG) return 3608 + n;
    if (map == MAP_VT) { if (n < 512) return 1024 + n; if (n < 640) return 2432 + (n - 512); if (n < 768) return 2688 + (n - 640); if (n < 896) return 3480 + (n - 768); return -1; }
    if (n < 512) { sc = QSCALE; return n; }
    if (n < 1024) return n;
    if (n < 1536) { sc = QSCALE; return 1536 + (n - 1024); }
    if (n < 1792) return 2048 + (n - 1536);
    if (n < 1920) return 2304 + (n - 1792);
    if (n < 2048) return 2560 + (n - 1920);
    if (n < 2560) { sc = QSCALE; return 2840 + (n - 2048); }
    if (n < 2688) return 3352 + (n - 2560);
    if (n < 2712) return 2816 + (n - 2688);
    return -1;
}
__device__ __forceinline__ void transpose_item(const float* W, int ldw, int K, int N, bf16_t* WT, int map, LAS float* scr, int item, int lane) {
    const int nblk = N / 32, kb = item / nblk, nb = item % nblk, k0 = 64 * kb, n0 = 32 * nb;
    float sc; const int sc_col = map_col(map, n0 + (lane & 31), sc);
#pragma unroll 8
    for (int i = 0; i < 32; ++i) { const int kk = 2 * i + (lane >> 5); scr[kk * 33 + (lane & 31)] = sc_col >= 0 ? W[(size_t)(k0 + kk) * ldw + sc_col] * sc : 0.f; }
    asm volatile("s_waitcnt lgkmcnt(0)" ::: "memory");
    const int cch = lane & 7;
#pragma unroll
    for (int j = 0; j < 4; ++j) { const int n = (lane >> 3) + 8 * j; const LAS float* s = scr + (8 * cch) * 33 + n;
        u32x4 o; o.x = pk2(s[0 * 33], s[1 * 33]); o.y = pk2(s[2 * 33], s[3 * 33]); o.z = pk2(s[4 * 33], s[5 * 33]); o.w = pk2(s[6 * 33], s[7 * 33]);
        *(u32x4*)(WT + (size_t)(n0 + n) * K + k0 + 8 * cch) = o; }
    asm volatile("s_waitcnt lgkmcnt(0)" ::: "memory");
}
struct ConvJob { const float* W; int ldw, K, N, map; bf16_t* WT; };
__device__ __forceinline__ void get_job(const Args& a, int l, int j, ConvJob& q) {
    bf16_t* wb = (bf16_t*)(a.ws + WS_W);
    const float* ffn_in = a.in[2] + (size_t)l * 2 * DM * 2 * DFF; const float* ffn_out = a.in[3] + (size_t)l * 2 * DFF * DM;
    const float* w_in = a.in[6] + (size_t)l * DM * DIN;
    const float* w1 = a.in[10] + (size_t)l * 2 * 2048 * 256; const float* w2 = a.in[11] + (size_t)l * 2 * 256 * 64;
    q.map = MAP_ID;
    switch (j) {
    case 0: q.W = ffn_in; q.ldw = 2 * DFF; q.K = DM; q.N = 2 * DFF; q.WT = wb + W_F1A; q.map = MAP_FFN; break;
    case 1: q.W = ffn_in + (size_t)DM * 2 * DFF; q.ldw = 2 * DFF; q.K = DM; q.N = 2 * DFF; q.WT = wb + W_F2A; q.map = MAP_FFN; break;
    case 2: q.W = ffn_out; q.ldw = DM; q.K = DFF; q.N = DM; q.WT = wb + W_F1B; break;
    case 3: q.W = ffn_out + (size_t)DFF * DM; q.ldw = DM; q.K = DFF; q.N = DM; q.WT = wb + W_F2B; break;
    case 4: q.W = w_in; q.ldw = DIN; q.K = DM; q.N = 2816; q.WT = wb + W_TOK; q.map = MAP_TOK; break;
    case 5: q.W = w_in; q.ldw = DIN; q.K = DM; q.N = 1024; q.WT = wb + W_VT; q.map = MAP_VT; break;
    case 6: q.W = w_in; q.ldw = DIN; q.K = DM; q.N = 3072; q.WT = wb + W_MG; q.map = MAP_MG; break;
    case 7: q.W = a.in[13] + (size_t)l * 1536 * DM; q.ldw = DM; q.K = 1536; q.N = DM; q.WT = wb + W_BR; break;
    case 8: q.W = a.in[14] + (size_t)l * DM * DM; q.ldw = DM; q.K = DM; q.N = DM; q.WT = wb + W_O; break;
    case 9: q.W = a.in[15] + (size_t)l * PLE * DM; q.ldw = DM; q.K = PLE; q.N = DM; q.WT = wb + W_PI; break;
    case 10: q.W = a.in[16] + (size_t)l * DM * DM; q.ldw = DM; q.K = DM; q.N = DM; q.WT = wb + W_PG; break;
    case 11: q.W = w1; q.ldw = 256; q.K = 2048; q.N = 256; q.WT = wb + W_C1; break;
    case 12: q.W = w1 + 2048 * 256; q.ldw = 256; q.K = 2048; q.N = 256; q.WT = wb + W_C1 + 256 * 2048; break;
    case 13: q.W = w2; q.ldw = 64; q.K = 256; q.N = 64; q.WT = wb + W_C2; break;
    default: q.W = w2 + 256 * 64; q.ldw = 64; q.K = 256; q.N = 64; q.WT = wb + W_C2 + 64 * 256; break;
    }
}
__device__ __forceinline__ void convert_layer(const Args& a, int l, LAS unsigned char* lds, int G) {
    const int tid = my_tid(), lane = tid & 63, wave = tid >> 6;
    LAS float* scr = (LAS float*)(lds + wave * 8448);
    const int gw = blockIdx.x * 8 + wave, NGW = G * 8;
#pragma unroll 1
    for (int j = 0; j < 15; ++j) {
        ConvJob q; get_job(a, l, j, q);
        const int items = (q.K / 64) * (q.N / 32);
#pragma unroll 1
        for (int it = gw; it < items; it += NGW) transpose_item(q.W, q.ldw, q.K, q.N, q.WT, q.map, scr, it, lane);
    }
    { const float* p = a.in[1] + (size_t)l * T * PLE; bf16_t* pb = (bf16_t*)(a.ws + WS_PB);
#pragma unroll 1
      for (size_t i = ((size_t)blockIdx.x * 512 + tid) * 8; i < (size_t)T * PLE; i += (size_t)G * 512 * 8) {
          const f32x4 v0 = *(const f32x4*)(p + i), v1 = *(const f32x4*)(p + i + 4);
          u32x4 w; w.x = pk2(v0[0], v0[1]); w.y = pk2(v0[2], v0[3]); w.z = pk2(v1[0], v1[1]); w.w = pk2(v1[2], v1[3]); *(u32x4*)(pb + i) = w; } }
    if (blockIdx.x < 64) { const float* w1 = a.in[10] + (size_t)l * 2 * 2048 * 256;
        const int fc = blockIdx.x, n = tid >> 8, h = tid & 255; const float* pos = a.in[9] + (size_t)l * 2 * 2048 + n * 2048 + fc * 32; const float* w = w1 + (size_t)n * 2048 * 256 + (size_t)(fc * 32) * 256 + h;
        float s = 0.f;
#pragma unroll 8
        for (int f = 0; f < 32; ++f) s += pos[f] * w[(size_t)f * 256];
        ((float*)(a.ws + WS_CBP))[fc * 512 + tid] = s; }
}

__device__ __forceinline__ void ln_phase(const float* src, const float* gam, const float* bet, float* dst, bf16_t* dstb, int G) {
    const int tid_ = my_tid(), lane = tid_ & 63, wave = tid_ >> 6;
    f32x4 gv[4], bv[4];
#pragma unroll
    for (int j = 0; j < 4; ++j) { gv[j] = *(const f32x4*)(gam + 4 * lane + 256 * j); bv[j] = *(const f32x4*)(bet + 4 * lane + 256 * j); }
    for (int row = blockIdx.x * 8 + wave; row < T; row += G * 8) {
        const float* xr = src + (size_t)row * DM + 4 * lane; f32x4 v[4]; float s = 0.f;
#pragma unroll
        for (int j = 0; j < 4; ++j) { v[j] = *(const f32x4*)(xr + 256 * j); s += (v[j][0] + v[j][1]) + (v[j][2] + v[j][3]); }
        const float mean = wave_sum(s) * (1.f / DM); float s2 = 0.f;
#pragma unroll
        for (int j = 0; j < 4; ++j) { v[j] = v[j] - mean; s2 += (v[j][0] * v[j][0] + v[j][1] * v[j][1]) + (v[j][2] * v[j][2] + v[j][3] * v[j][3]); }
        const float rstd = 1.0f / sqrtf(wave_sum(s2) * (1.f / DM) + 1e-5f);
#pragma unroll
        for (int j = 0; j < 4; ++j) { const f32x4 o = v[j] * rstd * gv[j] + bv[j]; *(f32x4*)(dst + (size_t)row * DM + 4 * lane + 256 * j) = o;
            u32x2 w; w.x = pk2(o[0], o[1]); w.y = pk2(o[2], o[3]); *(u32x2*)(dstb + (size_t)row * DM + 4 * lane + 256 * j) = w; }
    }
}

constexpr int AT_KB0 = 0, AT_VB0 = 17408, AT_BUF = 35840, AT_X = 71680, AT_MISC = 137216;
template <int DV> struct FlashSt { f32x16 o[DV / 32]; float m, l; };
template <int KW, int DV> struct StageRegs { u32x4 k[KW / 64]; u32x4 v[DV / 64]; };

template <int KW, int DV>
__device__ __forceinline__ void stage_load(StageRegs<KW, DV>& r, const bf16_t* kp, size_t ldk, const bf16_t* vp, size_t ldv, int tid) {
#pragma unroll
    for (int i = 0; i < KW / 64; ++i) { const int idx = tid + i * 512, key = idx / (KW / 8), ch = idx % (KW / 8); r.k[i] = *(const u32x4*)(kp + (size_t)key * ldk + ch * 8); }
#pragma unroll
    for (int i = 0; i < DV / 64; ++i) { const int idx = tid + i * 512, d = idx >> 3, kc = idx & 7; r.v[i] = *(const u32x4*)(vp + (size_t)d * ldv + kc * 8); }
}
template <int KW, int DV>
__device__ __forceinline__ void stage_store(const StageRegs<KW, DV>& r, LAS unsigned char* kb, LAS unsigned char* vb, int tid) {
    constexpr int KSTR = KW * 2 + 16, VSTR = 144;
#pragma unroll
    for (int i = 0; i < KW / 64; ++i) { const int idx = tid + i * 512, key = idx / (KW / 8), ch = idx % (KW / 8); *(LAS u32x4*)(kb + key * KSTR + ch * 16) = r.k[i]; }
#pragma unroll
    for (int i = 0; i < DV / 64; ++i) { const int idx = tid + i * 512, d = idx >> 3, kc = idx & 7; LAS unsigned char* p = vb + d * VSTR + (kc >> 1) * 32 + (kc & 1) * 8;
        *(LAS u32x2*)(p) = (u32x2){r.v[i].x, r.v[i].y}; *(LAS u32x2*)(p + 16) = (u32x2){r.v[i].z, r.v[i].w}; }
}
__device__ __forceinline__ bf16x8 pack8(const f32x16& s, int o) {
    u32x4 w; w.x = pk2(s[o + 0], s[o + 1]); w.y = pk2(s[o + 2], s[o + 3]); w.z = pk2(s[o + 4], s[o + 5]); w.w = pk2(s[o + 6], s[o + 7]);
    return __builtin_bit_cast(bf16x8, w);
}

template <int KW, int DV>
__device__ __forceinline__ void flash_block(FlashSt<DV>& st, const bf16x8 (&qf)[4], const LAS unsigned char* kb, const LAS unsigned char* vb, int koff, int kb0,
                                            int t, int tmin, int tmax, int W, float slope2, bool selok, bool anymask, int lane) {
    constexpr int KSTR = KW * 2 + 16, VSTR = 144;
    const int r = lane & 31, hf = lane >> 5;
    f32x16 s0 = zero16(), s1 = zero16();
    const LAS unsigned char* kp = kb + r * KSTR + koff + hf * 16;
#pragma unroll
    for (int ks = 0; ks < 4; ++ks) {
        const bf16x8 k0 = *(const LAS bf16x8*)(kp + ks * 32), k1 = *(const LAS bf16x8*)(kp + 32 * KSTR + ks * 32);
        s0 = mfma32(k0, qf[ks], s0); s1 = mfma32(k1, qf[ks], s1);
    }
    const int rel = t - kb0 - 4 * hf; const float relf = (float)rel;
    const bool edge = anymask || (kb0 + 63 > tmin) || (kb0 <= tmax - W);
    float mx = NINF;
#pragma unroll
    for (int i = 0; i < 16; ++i) {
        const int kc = (i & 3) + 8 * (i >> 2);
        float v0 = s0[i] - slope2 * (relf - (float)kc), v1 = s1[i] - slope2 * (relf - (float)(kc + 32));
        if (edge) { if (!(selok && kc <= rel && kc > rel - W)) v0 = NINF; if (!(selok && kc + 32 <= rel && kc + 32 > rel - W)) v1 = NINF; }
        s0[i] = v0; s1[i] = v1; mx = fmaxf(mx, fmaxf(v0, v1));
    }
    mx = fmaxf(mx, __shfl_xor(mx, 32));
    const float mnew = fmaxf(st.m, mx), msafe = (mnew == NINF) ? 0.f : mnew;
    const float alpha = fexp2(st.m - msafe);
    float ls = 0.f;
#pragma unroll
    for (int i = 0; i < 16; ++i) { s0[i] = fexp2(s0[i] - msafe); s1[i] = fexp2(s1[i] - msafe); ls += s0[i] + s1[i]; }
    st.l = st.l * alpha + ls; st.m = mnew;
#pragma unroll
    for (int db = 0; db < DV / 32; ++db) st.o[db] = st.o[db] * alpha;
    bf16x8 p[4]; p[0] = pack8(s0, 0); p[1] = pack8(s0, 8); p[2] = pack8(s1, 0); p[3] = pack8(s1, 8);
    const LAS unsigned char* vp = vb + r * VSTR + hf * 16;
#pragma unroll
    for (int db = 0; db < DV / 32; ++db)
#pragma unroll
        for (int g4 = 0; g4 < 4; ++g4) { const bf16x8 vf = *(const LAS bf16x8*)(vp + db * 32 * VSTR + g4 * 32); st.o[db] = mfma32(vf, p[g4], st.o[db]); }
}

template <int KW, int DV>
__device__ __forceinline__ void flash_run(LAS unsigned char* lds, FlashSt<DV>& st, const bf16x8 (&qf)[4], const bf16_t* kbase, size_t ldk, const bf16_t* vbase, size_t ldv,
                                          unsigned bits, unsigned selmask, bool use_sel, int t, int tmin, int tmax, int W, float slope2, int koff) {
    const int tid = my_tid(), lane = tid & 63;
    unsigned rem = bits;
    if (!rem) return;
    StageRegs<KW, DV> sr;
    int j = __builtin_ctz(rem); rem &= rem - 1;
    stage_load<KW, DV>(sr, kbase + (size_t)j * 64 * ldk, ldk, vbase + j * 64, ldv, tid);
    stage_store<KW, DV>(sr, lds + AT_KB0, lds + AT_VB0, tid);
    __syncthreads();
    int buf = 0;
    for (;;) {
        const int jn = rem ? __builtin_ctz(rem) : -1;
        if (jn >= 0) stage_load<KW, DV>(sr, kbase + (size_t)jn * 64 * ldk, ldk, vbase + jn * 64, ldv, tid);
        const int kb0 = j * 64;
        const bool skip = (kb0 > tmax) || (kb0 + 63 <= tmin - W);
        if (!skip) {
            const bool selok = use_sel ? ((selmask >> j) & 1u) : true;
            flash_block<KW, DV>(st, qf, lds + AT_KB0 + buf * AT_BUF, lds + AT_VB0 + buf * AT_BUF, koff, kb0, t, tmin, tmax, W, slope2, selok, use_sel, lane);
        }
        if (jn < 0) break;
        stage_store<KW, DV>(sr, lds + AT_KB0 + (buf ^ 1) * AT_BUF, lds + AT_VB0 + (buf ^ 1) * AT_BUF, tid);
        __syncthreads();
        buf ^= 1; j = jn; rem &= rem - 1;
    }
    __syncthreads();
}
__device__ __forceinline__ void load_q(bf16x8 (&qf)[4], const bf16_t* qrow, int hf) {
#pragma unroll
    for (int ks = 0; ks < 4; ++ks) qf[ks] = *(const bf16x8*)(qrow + ks * 16 + hf * 8);
}
template <int DV> __device__ __forceinline__ void flash_init(FlashSt<DV>& st) {
#pragma unroll
    for (int db = 0; db < DV / 32; ++db)
#pragma unroll
        for (int i = 0; i < 16; ++i) st.o[db][i] = 0.f;
    st.m = NINF; st.l = 0.f;
}
__device__ __forceinline__ unsigned range_bits(int lo, int hi) {
    const unsigned hi_m = (hi >= 31) ? 0xffffffffu : ((1u << (hi + 1)) - 1u); return hi_m & ~((1u << lo) - 1u);
}
__device__ __forceinline__ void store_o64(const f32x16 (&o)[2], bf16_t* orow, int hf) {
#pragma unroll
    for (int db = 0; db < 2; ++db)
#pragma unroll
        for (int q4 = 0; q4 < 4; ++q4) { u32x2 w; w.x = pk2(o[db][4 * q4], o[db][4 * q4 + 1]); w.y = pk2(o[db][4 * q4 + 2], o[db][4 * q4 + 3]);
            *(u32x2*)(orow + db * 32 + 8 * q4 + 4 * hf) = w; }
}

__device__ __forceinline__ void diff_item(const Args& a, int l, LAS unsigned char* lds, int b, int h, int qi) {
    const int tid = my_tid(), lane = tid & 63, wave = tid >> 6, mp = wave >> 2, wq = wave & 3, r = lane & 31, hf = lane >> 5;
    const bf16_t* qkv = (const bf16_t*)(a.ws + WS_A); const bf16_t* vt = (const bf16_t*)(a.ws + WS_VT); bf16_t* O = (bf16_t*)(a.ws + WS_B);
    const int q0 = qi * 128, tmin = q0 + wq * 32, tmax = tmin + 31, t = tmin + r;
    const float slope2 = fexp2(-2.0f * (float)(h + 1)) * LOG2E;
    const float lambda_init = 0.8f - 0.6f * __expf(-0.3f * (float)l);
    const float* lam = a.in[7] + l * 256;
    const float lam_full = __expf(wave_sum(lam[lane] * lam[64 + lane])) - __expf(wave_sum(lam[128 + lane] * lam[192 + lane])) + lambda_init;
    bf16x8 qf[4]; load_q(qf, qkv + (size_t)(b * SEQ + t) * LDQ + QA + h * 128 + mp * 64, hf);
    FlashSt<128> st; flash_init<128>(st);
    flash_run<128, 128>(lds, st, qf, qkv + (size_t)b * SEQ * LDQ + KA + h * 128, LDQ, vt + (size_t)(VA + h * 128) * T + (size_t)b * SEQ, T,
                        range_bits(0, 2 * qi + 1), 0u, false, t, tmin, tmax, 1 << 28, slope2, mp * 128);
    const float lt = st.l + __shfl_xor(st.l, 32); const float inv = 1.0f / lt;
    LAS float* xb = (LAS float*)(lds + AT_X) + wq * 4096 + lane;
    if (mp == 1) {
        const float f = inv * lam_full;
#pragma unroll
        for (int db = 0; db < 4; ++db)
#pragma unroll
            for (int i = 0; i < 16; ++i) xb[(db * 16 + i) * 64] = st.o[db][i] * f;
    }
    __syncthreads();
    if (mp == 0) {
        float ss = 0.f;
#pragma unroll
        for (int db = 0; db < 4; ++db)
#pragma unroll
            for (int i = 0; i < 16; ++i) { const float v = st.o[db][i] * inv - xb[(db * 16 + i) * 64]; st.o[db][i] = v; ss += v * v; }
        ss += __shfl_xor(ss, 32);
        const float rs = (DBG_ZERO & 1) ? 0.f : (1.0f / sqrtf(ss * (1.0f / 128.0f) + 1e-5f)) * (1.0f - lambda_init);
        const float* sg = a.in[8] + l * 128; bf16_t* orow = O + (size_t)(b * SEQ + t) * 1536 + h * 128;
#pragma unroll
        for (int db = 0; db < 4; ++db)
#pragma unroll
            for (int q4 = 0; q4 < 4; ++q4) { const int d = db * 32 + 8 * q4 + 4 * hf; const f32x4 gg = *(const f32x4*)(sg + d);
                u32x2 w; w.x = pk2(st.o[db][4 * q4] * rs * gg[0], st.o[db][4 * q4 + 1] * rs * gg[1]); w.y = pk2(st.o[db][4 * q4 + 2] * rs * gg[2], st.o[db][4 * q4 + 3] * rs * gg[3]);
                *(u32x2*)(orow + d) = w; }
    }
    __syncthreads();
}

__device__ __forceinline__ void swa_item(const Args& a, int l, LAS unsigned char* lds, int b, int g, int tb) {
    const int tid = my_tid(), lane = tid & 63, wave = tid >> 6, hd = wave & 3, th = wave >> 2, r = lane & 31, hf = lane >> 5;
    const bf16_t* qkv = (const bf16_t*)(a.ws + WS_A); const bf16_t* vt = (const bf16_t*)(a.ws + WS_VT); bf16_t* O = (bf16_t*)(a.ws + WS_B);
    const int head = g * 4 + hd, tmin = tb * 64 + th * 32, tmax = tmin + 31, t = tmin + r;
    const float slope2 = fexp2(-(float)(head + 1)) * LOG2E;
    bf16x8 qf[4]; load_q(qf, qkv + (size_t)(b * SEQ + t) * LDQ + QC + head * 64, hf);
    FlashSt<64> st; flash_init<64>(st);
    flash_run<64, 64>(lds, st, qf, qkv + (size_t)b * SEQ * LDQ + KCC + g * 64, LDQ, vt + (size_t)(VC + g * 64) * T + (size_t)b * SEQ, T,
                      range_bits(tb >= 2 ? tb - 2 : 0, tb), 0u, false, t, tmin, tmax, 128, slope2, 0);
    const float sink = a.in[12][l * 8 + head];
    const float lt = st.l + __shfl_xor(st.l, 32) + ((DBG_ZERO & 8) ? 0.f : fexp2(sink * LOG2E - st.m)); const float inv = 1.0f / lt;
    st.o[0] = st.o[0] * ((DBG_ZERO & 4) ? 0.f : inv); st.o[1] = st.o[1] * ((DBG_ZERO & 4) ? 0.f : inv);
    const int tp = (t & 127) * 16 + (t >> 7);
    store_o64(st.o, O + (size_t)(b * SEQ + tp) * 1536 + 1024 + head * 64, hf);
}

__device__ __forceinline__ void nsa_item(const Args& a, LAS unsigned char* lds, int b, int g, int tb) {
    const int tid = my_tid(), lane = tid & 63, wave = tid >> 6, hd = wave & 3, th = wave >> 2, r = lane & 31, hf = lane >> 5;
    const bf16_t* qkv = (const bf16_t*)(a.ws + WS_A); const bf16_t* vt = (const bf16_t*)(a.ws + WS_VT); bf16_t* O = (bf16_t*)(a.ws + WS_B);
    const bf16_t* KCb = (const bf16_t*)(a.ws + WS_KC) + (size_t)(b * 2 + g) * 128 * 64; const bf16_t* VCb = (const bf16_t*)(a.ws + WS_VCT) + (size_t)(b * 2 + g) * 64 * 128;
    const int head = g * 4 + hd, tl = th * 32 + r, tmin = tb * 64 + th * 32, tmax = tmin + 31, t = tmin + r;
    const float slope2 = fexp2(-(float)(head + 1)) * LOG2E;
    const bf16_t* trow = qkv + (size_t)(b * SEQ + t) * LDQ;
    bf16x8 qf[4]; load_q(qf, trow + QB + head * 64, hf);
    const float g0 = sigmoidf_(bf2f(trow[BG + head])), g1 = sigmoidf_(bf2f(trow[BG + 8 + head])), g2 = sigmoidf_(bf2f(trow[BG + 16 + head]));
    f32x16 out[2];
    const int ncb = (tb >= 16) ? 2 : 1;
    f32x16 sc[4];
#pragma unroll
    for (int sb = 0; sb < 4; ++sb) sc[sb] = zero16();
#pragma unroll
    for (int cb = 0; cb < 2; ++cb) if (cb < ncb) {
        const bf16_t* kp = KCb + (size_t)(cb * 64 + r) * 64 + hf * 8;
#pragma unroll
        for (int ks = 0; ks < 4; ++ks) { const bf16x8 k0 = *(const bf16x8*)(kp + ks * 16), k1 = *(const bf16x8*)(kp + 32 * 64 + ks * 16);
            sc[2 * cb] = mfma32(k0, qf[ks], sc[2 * cb]); sc[2 * cb + 1] = mfma32(k1, qf[ks], sc[2 * cb + 1]); }
    }
    float mx = NINF;
#pragma unroll
    for (int sb = 0; sb < 4; ++sb)
#pragma unroll
        for (int i = 0; i < 16; ++i) { const int c = sb * 32 + (i & 3) + 8 * (i >> 2) + 4 * hf; const int dist = t - 16 * c - 31;
            const float v = (dist >= 0 && sb < 2 * ncb) ? sc[sb][i] - slope2 * (float)dist : NINF; sc[sb][i] = v; mx = fmaxf(mx, v); }
    mx = fmaxf(mx, __shfl_xor(mx, 32));
    const float msafe = (mx == NINF) ? 0.f : mx;
    float ls = 0.f;
#pragma unroll
    for (int sb = 0; sb < 4; ++sb)
#pragma unroll
        for (int i = 0; i < 16; ++i) { const float p = fexp2(sc[sb][i] - msafe); sc[sb][i] = p; ls += p; }
    ls += __shfl_xor(ls, 32);
    const float invl = ls > 0.f ? 1.0f / ls : 0.f;
#pragma unroll
    for (int sb = 0; sb < 4; ++sb) sc[sb] = sc[sb] * invl;
    {
        LAS float* sl = (LAS float*)(lds + AT_X) + (hd * 64 + tl) * 32;
        float xprev = 0.f;
#pragma unroll
        for (int sb = 0; sb < 4; ++sb)
#pragma unroll
            for (int q4 = 0; q4 < 4; ++q4) {
                const float h3 = 0.5f * sc[sb][4 * q4 + 3];
                const float mainv = sc[sb][4 * q4] + sc[sb][4 * q4 + 1] + sc[sb][4 * q4 + 2] + h3;
                const float x = __shfl_xor(h3, 32);
                sl[sb * 8 + 2 * q4 + hf] = mainv + (hf ? x : xprev);
                xprev = x;
            }
    }
    out[0] = zero16(); out[1] = zero16();
#pragma unroll
    for (int cb = 0; cb < 2; ++cb) if (cb < ncb) {
        bf16x8 p[4]; p[0] = pack8(sc[2 * cb], 0); p[1] = pack8(sc[2 * cb], 8); p[2] = pack8(sc[2 * cb + 1], 0); p[3] = pack8(sc[2 * cb + 1], 8);
        const bf16_t* vp = VCb + (size_t)r * 128 + cb * 64 + hf * 4;
#pragma unroll
        for (int db = 0; db < 2; ++db)
#pragma unroll
            for (int g4 = 0; g4 < 4; ++g4) {
                const u32x2 lo = *(const u32x2*)(vp + db * 32 * 128 + g4 * 16), hi = *(const u32x2*)(vp + db * 32 * 128 + g4 * 16 + 8);
                const u32x4 w = (u32x4){lo.x, lo.y, hi.x, hi.y};
                out[db] = mfma32(__builtin_bit_cast(bf16x8, w), p[g4], out[db]); }
    }
    out[0] = out[0] * g0; out[1] = out[1] * g0;

    __syncthreads();
    LAS unsigned* selm = (LAS unsigned*)(lds + AT_MISC + 64);
    {
        const LAS float* sl = (const LAS float*)(lds + AT_X);
#pragma unroll 1
        for (int it = 0; it < 4; ++it) {
            const int tok = it * 16 + wave * 2 + hf, j = r;
            float s = ((sl[(0 * 64 + tok) * 32 + j] + sl[(1 * 64 + tok) * 32 + j]) + sl[(2 * 64 + tok) * 32 + j]) + sl[(3 * 64 + tok) * 32 + j];
            if (j == 0 || j == tb || j == tb - 1) s = 1e4f;
            if (j > tb) s = -1.0f;
            int rank = 0;
#pragma unroll
            for (int jj = 0; jj < 32; ++jj) { const float o = __shfl(s, (lane & 32) | jj); rank += (o > s || (o == s && jj < j)) ? 1 : 0; }
            const unsigned long long bal = __ballot(rank < 16);
            if (r == 0) selm[tok] = hf ? (unsigned)(bal >> 32) : (unsigned)bal;
        }
    }
    __syncthreads();
    if (hd == 0 && hf == 0) ((unsigned*)(a.ws + WS_SEL))[(size_t)(b * 2 + g) * SEQ + t] = selm[tl];
    {
        FlashSt<64> st; flash_init<64>(st);
        flash_run<64, 64>(lds, st, qf, qkv + (size_t)b * SEQ * LDQ + KWC + g * 64, LDQ, vt + (size_t)(VW + g * 64) * T + (size_t)b * SEQ, T,
                          range_bits(tb >= 8 ? tb - 8 : 0, tb), 0u, false, t, tmin, tmax, 512, slope2, 0);
        const float lt = st.l + __shfl_xor(st.l, 32); const float f = 1.0f / lt;
        st.o[0] = st.o[0] * f; st.o[1] = st.o[1] * f;
        const int tp = (t & 127) * 16 + (t >> 7);
        store_o64(st.o, (bf16_t*)(a.ws + WS_WIN) + (size_t)(b * SEQ + tp) * 512 + head * 64, hf);
    }
    store_o64(out, O + (size_t)(b * SEQ + t) * 1536 + 512 + head * 64, hf);
}

__device__ __forceinline__ void nsa_item_b(const Args& a, LAS unsigned char* lds, int b, int g, int tb) {
    const int tid = my_tid(), lane = tid & 63, wave = tid >> 6, hd = wave & 3, th = wave >> 2, r = lane & 31, hf = lane >> 5;
    const bf16_t* qkv = (const bf16_t*)(a.ws + WS_A); const bf16_t* vt = (const bf16_t*)(a.ws + WS_VT); bf16_t* O = (bf16_t*)(a.ws + WS_B);
    const unsigned* sel = (const unsigned*)(a.ws + WS_SEL) + (size_t)(b * 2 + g) * SEQ + tb * 64;
    const int head = g * 4 + hd, tl = th * 32 + r, tmin = tb * 64 + th * 32, tmax = tmin + 31, t = tmin + r;
    const float slope2 = fexp2(-(float)(head + 1)) * LOG2E;
    bf16x8 qf[4]; load_q(qf, qkv + (size_t)(b * SEQ + t) * LDQ + QB + head * 64, hf);
    const unsigned selmask = sel[tl];
    unsigned um = sel[lane];
#pragma unroll
    for (int o = 1; o < 64; o <<= 1) um |= __shfl_xor(um, o);
    um = __builtin_amdgcn_readfirstlane(um) & range_bits(0, tb);
    FlashSt<64> st; flash_init<64>(st);
    flash_run<64, 64>(lds, st, qf, qkv + (size_t)b * SEQ * LDQ + KS + g * 64, LDQ, vt + (size_t)(VS + g * 64) * T + (size_t)b * SEQ, T,
                      um, selmask, true, t, tmin, tmax, 1 << 28, slope2, 0);
    const float lt = st.l + __shfl_xor(st.l, 32); const float f = lt > 0.f ? 1.0f / lt : 0.f;
    const int tp = (t & 31) * 64 + (t >> 5);
    const size_t rowp = (size_t)(b * SEQ + tp);
    const bf16_t* trow = qkv + rowp * LDQ;
    const float g1 = sigmoidf_(bf2f(trow[BG + 8 + head])) * f, g2 = sigmoidf_(bf2f(trow[BG + 16 + head]));
    bf16_t* orow = O + rowp * 1536 + 512 + head * 64; const bf16_t* wrow = (const bf16_t*)(a.ws + WS_WIN) + rowp * 512 + head * 64;
#pragma unroll
    for (int db = 0; db < 2; ++db)
#pragma unroll
        for (int q4 = 0; q4 < 4; ++q4) { const int d = db * 32 + 8 * q4 + 4 * hf;
            const u32x2 cw = *(const u32x2*)(orow + d), ww = *(const u32x2*)(wrow + d);
            const float v0 = bflo(cw.x) + g1 * st.o[db][4 * q4] + g2 * bflo(ww.x), v1 = bfhi(cw.x) + g1 * st.o[db][4 * q4 + 1] + g2 * bfhi(ww.x);
            const float v2 = bflo(cw.y) + g1 * st.o[db][4 * q4 + 2] + g2 * bflo(ww.y), v3 = bfhi(cw.y) + g1 * st.o[db][4 * q4 + 3] + g2 * bfhi(ww.y);
            u32x2 w; w.x = pk2(v0, v1); w.y = pk2(v2, v3); *(u32x2*)(orow + d) = w; }
}

__device__ __forceinline__ void attn_phase(const Args& a, int l, LAS unsigned char* lds, int pass, int rep = 0) {
    unsigned* ctr = (unsigned*)(a.ws + WS_CTL) + 64 * (l + 1) + 32 * pass + 8 * rep;
    LAS unsigned* qslot = (LAS unsigned*)(lds + AT_MISC);
    const unsigned nitems = pass ? 1024u : 3072u;
    for (;;) {
        if (my_tid() == 0) *qslot = atomicAdd(ctr, 1u);
        __syncthreads();
        const unsigned q = *qslot;
        __syncthreads();
        if (q >= nitems) break;
        if (pass) { nsa_item_b(a, lds, (q & 31) >> 1, q & 1, 31 - (q >> 5)); continue; }
        if (q < 2048u) {
            const int s = q >> 6, rr = q & 63;
            if (rr < 32) nsa_item(a, lds, rr >> 1, rr & 1, 31 - s);
            else { const int bh = (s & 1) * 32 + (rr - 32); diff_item(a, l, lds, bh >> 2, bh & 3, 15 - (s >> 1)); }
        } else { const int x = q - 2048; swa_item(a, l, lds, x >> 6, (x >> 5) & 1, x & 31); }
    }
}

__device__ __forceinline__ void cmp_gemm2(const Args& a) {
    const int c = blockIdx.x; if (c >= 32) return;
    const int tid_ = my_tid(), n = c >> 4, rt = c & 15, lane = tid_ & 63, wave = tid_ >> 6, r = lane & 31, hf = lane >> 5;
    const bf16_t* hid = (const bf16_t*)(a.ws + WS_HID) + ((size_t)n * 4096 + rt * 256 + wave * 32) * 256;
    const bf16_t* w2 = (const bf16_t*)(a.ws + WS_W) + W_C2 + n * 64 * 256;
    f32x16 acc[2]; acc[0] = zero16(); acc[1] = zero16();
#pragma unroll 4
    for (int ks = 0; ks < 16; ++ks) {
        const bf16x8 hf8 = *(const bf16x8*)(hid + (size_t)r * 256 + ks * 16 + hf * 8);
        const bf16x8 w0 = *(const bf16x8*)(w2 + (size_t)r * 256 + ks * 16 + hf * 8), w1 = *(const bf16x8*)(w2 + (size_t)(32 + r) * 256 + ks * 16 + hf * 8);
        acc[0] = mfma32(hf8, w0, acc[0]); acc[1] = mfma32(hf8, w1, acc[1]);
    }
    const int R0 = rt * 256 + wave * 32, gg = R0 >> 11, bb = (R0 >> 7) & 15, cc0 = R0 & 127;
    if (n == 0) {
        bf16_t* kp = (bf16_t*)(a.ws + WS_KC) + ((size_t)(bb * 2 + gg) * 128 + cc0 + 4 * hf) * 64 + r;
#pragma unroll
        for (int db = 0; db < 2; ++db)
#pragma unroll
            for (int i = 0; i < 16; ++i) kp[((i & 3) + 8 * (i >> 2)) * 64 + db * 32] = (bf16_t)(pk2(acc[db][i], 0.f) & 0xffffu);
    } else {
#pragma unroll
        for (int db = 0; db < 2; ++db) {
            bf16_t* vp = (bf16_t*)(a.ws + WS_VCT) + ((size_t)(bb * 2 + gg) * 64 + db * 32 + r) * 128 + cc0 + 4 * hf;
#pragma unroll
            for (int i = 0; i < 16; ++i) vp[(i & 3) + 8 * (i >> 2)] = (bf16_t)(pk2(acc[db][i], 0.f) & 0xffffu);
        }
    }
}


constexpr int NPH = 31;
__device__ __forceinline__ void gd_build(GemmDesc& g, const Args& a, int l, int p, int gi) {
    unsigned char* ws = a.ws;
    bf16_t* wb = (bf16_t*)(ws + WS_W); bf16_t* xb = (bf16_t*)(ws + WS_XB);
    bf16_t* RA = (bf16_t*)(ws + WS_A); bf16_t* hb = (bf16_t*)(ws + WS_VT); float* V = (float*)(ws + WS_B);
    const size_t T1K = (size_t)256 * 1024 * 2;
    g.A = (const char*)xb; g.Bt = nullptr; g.lda = 1024; g.ldb = 1024; g.ksA = 128; g.nt = 16; g.nM = 128; g.nN = 4; g.nz = 1; g.cmp = 0; g.perm = 1; g.mode = EP_BF16;
    g.a_tile = T1K; g.b_tile = T1K; g.a_z = 0; g.b_z = 0; g.f0 = V; g.xres = a.out; g.o16 = RA; g.bias = nullptr; g.ldc = 1024; g.scale = 1.f;
    switch (p) {
    case 0: case 11: g.Bt = (const char*)(wb + (p == 0 ? W_F1A : W_F2A)); g.nN = 22; g.mode = EP_SWIGLU; g.ldc = DFF; break;
    case 1: case 12: g.A = (const char*)RA; g.lda = DFF; g.Bt = (const char*)(wb + (p == 1 ? W_F1B : W_F2B)); g.ldb = DFF; g.nt = 44;
        g.a_tile = (size_t)256 * DFF * 2; g.b_tile = (size_t)256 * DFF * 2; g.mode = EP_RES; g.perm = 0; g.xres = (l == 0 && p == 1) ? a.in[0] : a.out; g.scale = 0.5f; g.o16 = (p == 12) ? hb : nullptr; break;
    case 3:
        if (gi == 0) { g.Bt = (const char*)(wb + W_TOK); g.nN = 11; g.ldc = LDQ; }
        else { g.A = (const char*)(wb + W_VT); g.Bt = (const char*)xb; g.nM = 4; g.nN = 128; g.o16 = (bf16_t*)(ws + WS_VT); g.ldc = T; }
        break;
    case 4: g.cmp = 1; g.A = (const char*)(RA + KVC); g.lda = 16 * LDQ; g.ksA = LDQ * 2; g.nt = 32; g.a_tile = (size_t)256 * 16 * LDQ * 2;
        g.Bt = (const char*)(wb + W_C1); g.ldb = 2048; g.b_z = (size_t)256 * 2048 * 2; g.mode = EP_GELU; g.o16 = (bf16_t*)(ws + WS_HID); g.ldc = 256; g.bias = (const float*)(ws + WS_CB); break;
    case 7: g.Bt = (const char*)(wb + W_MG); g.nN = 12; g.mode = EP_SIG16; g.ldc = 3072; break;
    case 8: g.A = (const char*)(ws + WS_B); g.lda = 1536; g.Bt = (const char*)(wb + W_BR); g.ldb = 1536; g.nt = 8; g.nz = 3; g.a_tile = (size_t)256 * 1536 * 2; g.b_tile = (size_t)256 * 1536 * 2;
        g.a_z = 1024; g.b_z = 1024; g.mode = EP_BRANCH; g.ldc = 3072; break;
    case 9: g.A = (const char*)RA; g.lda = 3072; g.Bt = (const char*)(wb + W_O); g.a_tile = (size_t)256 * 3072 * 2; g.mode = EP_RES; g.perm = 0; g.o16 = nullptr; break;
    default:
        if (gi == 0) { g.A = (const char*)(ws + WS_PB); g.lda = 256; g.Bt = (const char*)(wb + W_PI); g.ldb = 256; g.nt = 4; g.a_tile = (size_t)256 * 256 * 2; g.b_tile = (size_t)256 * 256 * 2; g.mode = EP_PE16; g.perm = 0; }
        else { g.A = (const char*)hb; g.Bt = (const char*)(wb + W_PG); g.mode = EP_PLEGATE; g.perm = 0; }
        break;
    }
}

__global__ void __launch_bounds__(512) fwd_kernel(Args a_kernarg) {
    extern __shared__ __attribute__((aligned(16))) unsigned char lds_raw[];
    LAS unsigned char* lds = (LAS unsigned char*)lds_raw;
    const int G = gridDim.x, c = blockIdx.x;
    const int ph_lo = a_kernarg.ph_lo, ph_hi = a_kernarg.ph_hi;
#pragma unroll 1
    for (int ph = ph_lo; ph < ph_hi; ++ph) {
        if (ph > ph_lo) {
            asm volatile("s_waitcnt vmcnt(0) lgkmcnt(0)" ::: "memory");
            cg::this_grid().sync();
        }
        const Args a = load_args();
        const int l = ph == 0 ? 0 : (ph - 1) / 15, p = ph == 0 ? -1 : (ph - 1) % 15;
        if (ph == 0) {
            const float* x = a.in[0]; bf16_t* xb = (bf16_t*)(a.ws + WS_XB); const int tid = my_tid();
#pragma unroll 1
            for (size_t i = ((size_t)c * 512 + tid) * 8; i < (size_t)T * DM; i += (size_t)G * 512 * 8) {
                const f32x4 v0 = *(const f32x4*)(x + i), v1 = *(const f32x4*)(x + i + 4);
                u32x4 w; w.x = pk2(v0[0], v0[1]); w.y = pk2(v0[2], v0[3]); w.z = pk2(v1[0], v1[1]); w.w = pk2(v1[2], v1[3]); *(u32x4*)(xb + i) = w; }
        }
        if (p == 2 || p == 10 || p == 14) {
            if (p == 2 && c == 0) { float s = 0.f; const int tid = my_tid(); const float* part = (const float*)(a.ws + WS_CBP);
#pragma unroll 8
                for (int f = 0; f < 64; ++f) s += part[f * 512 + tid];
                ((float*)(a.ws + WS_CB))[tid] = s; }
            const int k = (p == 2) ? 0 : (p == 10 ? 1 : 2);
            ln_phase((const float*)(a.ws + WS_B), a.in[4] + (l * 3 + k) * DM, a.in[5] + (l * 3 + k) * DM, a.out, (bf16_t*)(a.ws + WS_XB), G);
        }
        if (ph == 0 || (p == 14 && l == 0)) convert_layer(a, ph == 0 ? 0 : 1, lds, G);
#ifdef DBG_DOUBLE_C
        if (ph == 0 || (p == 14 && l == 0)) { cg::this_grid().sync(); convert_layer(a, ph == 0 ? 0 : 1, lds, G); }
#endif
        if (p == 5 || p == 6) attn_phase(a, l, lds, p - 5);
#ifdef DBG_DOUBLE_A
        if (p == 5) { cg::this_grid().sync(); attn_phase(a, l, lds, 0, 1); }
#endif
        const int ngemm = (p == 0 || p == 1 || p == 4 || p == 7 || p == 8 || p == 9 || p == 11 || p == 12) ? 1 : ((p == 3 || p == 13) ? 2 : 0);
#pragma unroll 1
        for (int gi = 0; gi < ngemm; ++gi) gemm_phase(lds, l, p, gi, c, G);
#ifdef DBG_DOUBLE_G
        if (p == 0 || p == 1 || p == 3 || p == 7 || p == 11 || p == 12) { cg::this_grid().sync(); for (int gi = 0; gi < ngemm; ++gi) gemm_phase(lds, l, p, gi, c, G); }
#endif
        if (p == 4) { __threadfence(); __syncthreads(); cmp_gemm2(load_args()); }
    }
}

extern "C" void kernel_launch(void* const* d_in, const int* in_sizes, int n_in, void* d_out, int out_size, void* d_ws, size_t ws_size, hipStream_t stream) {
    static int grid = 0;
    if (grid == 0) {
        int dev = 0, cus = 0;
        hipGetDevice(&dev); hipDeviceGetAttribute(&cus, hipDeviceAttributeMultiprocessorCount, dev);
        if (hipFuncSetAttribute((const void*)fwd_kernel, hipFuncAttributeMaxDynamicSharedMemorySize, LDS_BYTES) != hipSuccess) fprintf(stderr, "kernel_launch: hipFuncSetAttribute failed\n");
        int per_cu = 0; hipOccupancyMaxActiveBlocksPerMultiprocessor(&per_cu, (const void*)fwd_kernel, 512, LDS_BYTES); (void)hipGetLastError();
        grid = cus > 0 ? cus : 256;
        if (ws_size < WS_END) { fprintf(stderr, "kernel_launch: workspace too small: %zu < %zu\n", ws_size, (size_t)WS_END); grid = -1; }
        if (n_in != 17) { fprintf(stderr, "kernel_launch: expected 17 inputs\n"); grid = -1; }
    }
    if (grid < 0) return;
    hipMemsetAsync((char*)d_ws + WS_CTL, 0, 4096, stream);
    Args a{};
    for (int i = 0; i < 17; ++i) a.in[i] = (const float*)d_in[i];
    a.out = (float*)d_out; a.ws = (unsigned char*)d_ws;
#if N_LAUNCH_MODE == 0
    a.ph_lo = 0; a.ph_hi = NPH;
    void* args[] = {&a};
    hipError_t e = hipLaunchCooperativeKernel((const void*)fwd_kernel, dim3(grid), dim3(512), args, LDS_BYTES, stream);
    if (e != hipSuccess) fprintf(stderr, "cooperative launch failed: %s (grid %d)\n", hipGetErrorString(e), grid);
#else
    for (int ph = 0; ph < NPH; ++ph) { a.ph_lo = ph; a.ph_hi = ph + 1; hipLaunchKernelGGL(fwd_kernel, dim3(grid), dim3(512), LDS_BYTES, stream, a); }

#endif
}
```

```cpp
#include <hip/hip_runtime.h>
#include <hip/hip_cooperative_groups.h>
#include <cstdio>
#include <cstdint>
namespace cg = cooperative_groups;

#define LAS __attribute__((address_space(3)))
typedef unsigned short bf16_t;
typedef short bf16x8 __attribute__((ext_vector_type(8)));
typedef float f32x4 __attribute__((ext_vector_type(4)));
typedef float f32x16 __attribute__((ext_vector_type(16)));
typedef unsigned u32x4 __attribute__((ext_vector_type(4)));
typedef unsigned u32x2 __attribute__((ext_vector_type(2)));

#ifndef DBG_ZERO
#define DBG_ZERO 0
#endif
#ifndef STATIC_QUEUE
#define STATIC_QUEUE 0
#endif
#ifndef N_LAUNCH_MODE
#define N_LAUNCH_MODE 0
#endif

constexpr int T = 32768, DM = 1024, SEQ = 2048, NB = 16, DFF = 2816, PLE = 256;
constexpr int LDQ = 2816;
constexpr int QA = 0, KA = 512, QB = 1024, KVC = 1536, KS = 1792, KWC = 1920, QC = 2048, KCC = 2560, BG = 2688;
constexpr int VA = 0, VS = 512, VW = 640, VC = 768;
constexpr int DIN = 6680;
constexpr float LOG2E = 1.4426950408889634f;
constexpr float QSCALE = 0.125f * LOG2E;
constexpr float ALPHA = 1.4142135623730951f;
constexpr float NINF = -__builtin_inff();
constexpr int LDS_BYTES = 147456;

constexpr size_t WS_CTL = 0;
constexpr size_t WS_CB = 4096;
constexpr size_t WS_CBP = WS_CB + 2048;
constexpr size_t WS_W = WS_CBP + 64 * 512 * 4;
constexpr size_t W_F1A = 0, W_F1B = W_F1A + 5767168, W_F2A = W_F1B + 2883584, W_F2B = W_F2A + 5767168, W_TOK = W_F2B + 2883584,
                 W_VT = W_TOK + 2883584, W_MG = W_VT + 1048576, W_BR = W_MG + 3145728, W_O = W_BR + 1572864, W_PI = W_O + 1048576,
                 W_PG = W_PI + 262144, W_C1 = W_PG + 1048576, W_C2 = W_C1 + 1048576, W_END = W_C2 + 32768;
constexpr size_t WS_PB = WS_W + W_END * 2;
constexpr size_t WS_XB = WS_PB + (size_t)T * PLE * 2;
constexpr size_t WS_A = WS_XB + (size_t)T * DM * 2;
constexpr size_t WS_VT = WS_A + (size_t)T * LDQ * 2;
constexpr size_t WS_B = WS_A + (size_t)T * LDQ * 2 + (size_t)1024 * T * 2;
constexpr size_t WS_KC = WS_B + (size_t)T * DM * 4;
constexpr size_t WS_VCT = WS_KC + 524288;
constexpr size_t WS_HID = WS_VCT + 524288;
constexpr size_t WS_SEL = WS_HID + 4194304;
constexpr size_t WS_WIN = WS_B + (size_t)T * 1536 * 2;
constexpr size_t WS_END = WS_SEL + 262144;

struct Args {
    const float* in[17];
    float* out; unsigned char* ws;
    int ph_lo, ph_hi;
};

#define CAS __attribute__((address_space(4)))
__device__ __forceinline__ Args load_args() {
#if defined(__HIP_DEVICE_COMPILE__)
    const CAS Args* kp = (const CAS Args*)__builtin_amdgcn_kernarg_segment_ptr();
    asm volatile("" : "+s"(kp));
    Args r;
#pragma unroll
    for (int i = 0; i < 17; ++i) r.in[i] = kp->in[i];
    r.out = kp->out; r.ws = kp->ws; r.ph_lo = kp->ph_lo; r.ph_hi = kp->ph_hi;
    return r;
#else
    return Args{};
#endif
}
template <class X> __device__ __forceinline__ X launder_s(X v) { asm volatile("" : "+s"(v)); return v; }
__device__ __forceinline__ int my_tid() { int t = threadIdx.x; asm volatile("" : "+v"(t)); return t; }
typedef float f32x2_t __attribute__((ext_vector_type(2)));
typedef __bf16 bf16x2_t __attribute__((ext_vector_type(2)));
__device__ __forceinline__ unsigned pk2(float lo, float hi) { const f32x2_t v = {lo, hi}; return __builtin_bit_cast(unsigned, __builtin_convertvector(v, bf16x2_t)); }
__device__ __forceinline__ float bf2f(bf16_t v) { return __uint_as_float(((unsigned)v) << 16); }
__device__ __forceinline__ float bflo(unsigned w) { return __uint_as_float(w << 16); }
__device__ __forceinline__ float bfhi(unsigned w) { return __uint_as_float(w & 0xffff0000u); }
__device__ __forceinline__ float fexp2(float x) { return __builtin_amdgcn_exp2f(x); }
__device__ __forceinline__ float frcp(float x) { return __builtin_amdgcn_rcpf(x); }
__device__ __forceinline__ float sigmoidf_(float x) { return frcp(1.0f + fexp2(-x * LOG2E)); }
__device__ __forceinline__ float gelu_tanh(float x) { const float u = 1.5957691216057308f * (x + 0.044715f * x * x * x); return x * sigmoidf_(u); }
__device__ __forceinline__ f32x16 zero16() {
    f32x16 z;
#pragma unroll
    for (int i = 0; i < 16; ++i) z[i] = 0.f;
    asm volatile("" : "+v"(z));
    return z;
}
__device__ __forceinline__ f32x16 mfma32(bf16x8 a, bf16x8 b, f32x16 c) { return __builtin_amdgcn_mfma_f32_32x32x16_bf16(a, b, c, 0, 0, 0); }
__device__ __forceinline__ float wave_sum(float v) {
#pragma unroll
    for (int o = 1; o < 64; o <<= 1) v += __shfl_xor(v, o);
    return v;
}

namespace pg8 {
constexpr int BM = 256, BK = 64, HALF = 128, HTB = HALF * BK * 2, NXCD = 8, WGM = 8;
__device__ __forceinline__ int lds_byte(int r, int c) { const int st = (r >> 4) * 2 + (c >> 5), rr = r & 15, cc = c & 31, ob = rr * 64 + cc * 2; return st * 1024 + (ob ^ (((ob >> 9) & 1) << 5)); }
__device__ __forceinline__ void stage_rc(int b, int& R, int& C) { const int st = b / 1024, sb = b % 1024, swz = sb ^ (((sb >> 9) & 1) << 5); R = (st >> 1) * 16 + swz / 64; C = (st & 1) * 32 + (swz % 64) / 2; }
__device__ __forceinline__ int perm32(int rho) { const int n = rho >> 4, i = rho & 15; return 8 * (i >> 2) + 4 * n + (i & 3); }
}
enum { EP_SWIGLU = 0, EP_RES = 1, EP_BF16 = 2, EP_SIG16 = 3, EP_BRANCH = 4, EP_GELU = 5, EP_PE16 = 6, EP_PLEGATE = 7 };
struct GemmDesc {
    const char* A; const char* Bt;
    unsigned lda, ldb, ksA;
    int nt, nM, nN, nz, cmp, perm, mode;
    size_t a_tile, b_tile, a_z, b_z;
    float* f0; const float* xres; bf16_t* o16; const float* bias;
    int ldc; float scale;
};
struct Unit { int pm, pn, z; const char* a; const char* b; };

__device__ __forceinline__ bool gnext(const GemmDesc& g, int c, int G, int i, Unit& u) {
    if (g.cmp) {
        if (i != 0 || c >= 32) return false;
        const int n = c >> 4, rt = c & 15; u.pm = rt; u.pn = 0; u.z = n;
        u.a = g.A + n * 256 + (rt >> 3) * 128 + (size_t)(rt & 7) * g.a_tile; u.b = g.Bt + (size_t)n * g.b_z; return true;
    }
    int ti = i, z = 0; if (g.nz > 1) { ti = i / g.nz; z = i - ti * g.nz; }
    const int nwg = g.nM * g.nN; const long L = (long)ti * G + c; if (L >= nwg) return false;
    int wgid = (int)L; { const int q = nwg / pg8::NXCD, r = nwg % pg8::NXCD, xcd = wgid % pg8::NXCD, off = wgid / pg8::NXCD; wgid = (xcd < r ? xcd * (q + 1) : r * (q + 1) + (xcd - r) * q) + off; }
    const int nig = pg8::WGM * g.nN, gid = wgid / nig, fm = gid * pg8::WGM, gsz = (g.nM - fm) < pg8::WGM ? (g.nM - fm) : pg8::WGM;
    u.pm = fm + ((wgid % nig) % gsz); u.pn = (wgid % nig) / gsz; u.z = z;
    u.a = g.A + (size_t)u.pm * g.a_tile + (size_t)z * g.a_z; u.b = g.Bt + (size_t)u.pn * g.b_tile + (size_t)z * g.b_z; return true;
}

__device__ __forceinline__ void gemm_epilogue(const GemmDesc& g, const f32x4 (&acc)[2][2][4][2], const Unit& u, int wr, int wc, int fr, int fq) {
    const int row0 = u.pm * 256 + wr * 64 + fr;
    if (g.mode == EP_SWIGLU) {
        const int col0 = u.pn * 128 + wc * 32 + 8 * fq;
#pragma unroll
        for (int ai = 0; ai < 2; ++ai)
#pragma unroll
            for (int m = 0; m < 4; ++m) {
                float o[8];
#pragma unroll
                for (int n = 0; n < 2; ++n)
#pragma unroll
                    for (int j = 0; j < 4; ++j) { const float gt = acc[ai][0][m][n][j], up = acc[ai][1][m][n][j]; o[4 * n + j] = gt * sigmoidf_(gt) * up; }
                u32x4 w; w.x = pk2(o[0], o[1]); w.y = pk2(o[2], o[3]); w.z = pk2(o[4], o[5]); w.w = pk2(o[6], o[7]);
                *(u32x4*)(g.o16 + (size_t)(row0 + ai * 128 + m * 16) * g.ldc + col0) = w;
            }
    } else if (g.mode == EP_BF16 || g.mode == EP_SIG16 || g.mode == EP_GELU) {
        const int col0 = u.pn * 256 + wc * 32 + 8 * fq;
        bf16_t* base = g.o16; f32x4 bv[2][2];
#pragma unroll
        for (int bj = 0; bj < 2; ++bj)
#pragma unroll
            for (int n = 0; n < 2; ++n) bv[bj][n] = (f32x4){0.f, 0.f, 0.f, 0.f};
        if (g.mode == EP_GELU) {
            base += (size_t)u.z * 4096 * 256;
#pragma unroll
            for (int bj = 0; bj < 2; ++bj)
#pragma unroll
                for (int n = 0; n < 2; ++n) bv[bj][n] = *(const f32x4*)(g.bias + u.z * 256 + col0 + bj * 128 + 4 * n);
        }
#pragma unroll
        for (int ai = 0; ai < 2; ++ai)
#pragma unroll
            for (int m = 0; m < 4; ++m) {
                bf16_t* rowp = base + (size_t)(row0 + ai * 128 + m * 16) * g.ldc + col0;
#pragma unroll
                for (int bj = 0; bj < 2; ++bj) {
                    f32x4 v0 = acc[ai][bj][m][0] + bv[bj][0], v1 = acc[ai][bj][m][1] + bv[bj][1];
                    if (g.mode == EP_SIG16) {
#pragma unroll
                        for (int j = 0; j < 4; ++j) { v0[j] = sigmoidf_(v0[j]); v1[j] = sigmoidf_(v1[j]); }
                    } else if (g.mode == EP_GELU) {
#pragma unroll
                        for (int j = 0; j < 4; ++j) { v0[j] = gelu_tanh(v0[j]); v1[j] = gelu_tanh(v1[j]); }
                    }
                    u32x4 w; w.x = pk2(v0[0], v0[1]); w.y = pk2(v0[2], v0[3]); w.z = pk2(v1[0], v1[1]); w.w = pk2(v1[2], v1[3]);
                    *(u32x4*)(rowp + bj * 128) = w;
                }
            }
    } else if (g.mode == EP_BRANCH) {
        const int col0 = u.pn * 256 + wc * 32 + 8 * fq;
#pragma unroll
        for (int ai = 0; ai < 2; ++ai)
#pragma unroll
            for (int m = 0; m < 4; ++m) {
                bf16_t* rowp = g.o16 + (size_t)(row0 + ai * 128 + m * 16) * g.ldc + col0;
#pragma unroll
                for (int bj = 0; bj < 2; ++bj) {
                    const u32x4 gw = *(const u32x4*)(rowp + u.z * 1024 + bj * 128);
                    f32x4 v0 = acc[ai][bj][m][0], v1 = acc[ai][bj][m][1];
                    v0[0] *= bflo(gw.x); v0[1] *= bfhi(gw.x); v0[2] *= bflo(gw.y); v0[3] *= bfhi(gw.y);
                    v1[0] *= bflo(gw.z); v1[1] *= bfhi(gw.z); v1[2] *= bflo(gw.w); v1[3] *= bfhi(gw.w);
                    if (u.z > 0) {
                        const u32x4 pw = *(const u32x4*)(rowp + bj * 128);
                        v0[0] += bflo(pw.x); v0[1] += bfhi(pw.x); v0[2] += bflo(pw.y); v0[3] += bfhi(pw.y);
                        v1[0] += bflo(pw.z); v1[1] += bfhi(pw.z); v1[2] += bflo(pw.w); v1[3] += bfhi(pw.w);
                    }
                    u32x4 w; w.x = pk2(v0[0], v0[1]); w.y = pk2(v0[2], v0[3]); w.z = pk2(v1[0], v1[1]); w.w = pk2(v1[2], v1[3]);
                    *(u32x4*)(rowp + bj * 128) = w;
                }
            }
    } else {
        const int col0 = u.pn * 256 + wc * 32 + 4 * fq;
#pragma unroll
        for (int ai = 0; ai < 2; ++ai)
#pragma unroll
            for (int m = 0; m < 4; ++m) {
                const size_t off = (size_t)(row0 + ai * 128 + m * 16) * g.ldc + col0;
#pragma unroll
                for (int bj = 0; bj < 2; ++bj)
#pragma unroll
                    for (int n = 0; n < 2; ++n) {
                        const size_t o = off + bj * 128 + n * 16; const f32x4 a = acc[ai][bj][m][n];
                        if (g.mode == EP_RES) {
                            const f32x4 xr = *(const f32x4*)(g.xres + o); const f32x4 v = xr * ALPHA + a * g.scale;
                            *(f32x4*)(g.f0 + o) = v;
                            if (g.o16) { u32x2 w; w.x = pk2(v[0], v[1]); w.y = pk2(v[2], v[3]); *(u32x2*)(g.o16 + o) = w; }
                        } else if (g.mode == EP_PE16) {
                            u32x2 w; w.x = pk2(a[0], a[1]); w.y = pk2(a[2], a[3]); *(u32x2*)(g.o16 + o) = w;
                        } else {
                            const u32x2 pw = *(const u32x2*)(g.o16 + o); f32x4 v = *(const f32x4*)(g.f0 + o);
                            v[0] += sigmoidf_(a[0]) * bflo(pw.x); v[1] += sigmoidf_(a[1]) * bfhi(pw.x); v[2] += sigmoidf_(a[2]) * bflo(pw.y); v[3] += sigmoidf_(a[3]) * bfhi(pw.y);
                            *(f32x4*)(g.f0 + o) = v;
                        }
                    }
            }
    }
}

__device__ __forceinline__ void gd_build(GemmDesc& g, const Args& a, int l, int p, int gi);
__device__ __forceinline__ void gemm_phase(LAS unsigned char* lds, int l, int p, int gi, int c, int G) {
    using namespace pg8;
    const int tid = my_tid(), wid = __builtin_amdgcn_readfirstlane(tid >> 6), lane = tid & 63, wr = wid >> 2, wc = wid & 3, fr = lane & 15, fq = lane >> 4;
    Unit cur, nxt; int ui = 0;
    unsigned voffA[2], voffB[2]; int nt; size_t kstepA, hstepA, hstepB; const size_t kstepB = 128;
    { GemmDesc g; gd_build(g, load_args(), l, p, gi);
      if (!gnext(g, c, G, 0, cur)) return;
      nt = g.nt;
#pragma unroll
      for (int i = 0; i < 2; ++i) { int R, C; stage_rc(tid * 16 + i * 8192, R, C); const int Rb = g.perm ? ((R & ~31) + perm32(R & 31)) : R;
          voffA[i] = (unsigned)(R * g.lda + C) * 2u; voffB[i] = (unsigned)(Rb * g.ldb + C) * 2u; }
      kstepA = g.ksA; hstepA = (size_t)HALF * g.lda * 2; hstepB = (size_t)HALF * g.ldb * 2; }
    const unsigned ldsw = (unsigned)wid * 1024u;
    const int aoff = lds_byte(wr * 64 + fr, fq * 8), boff = lds_byte(wc * 32 + fr, fq * 8);
#define PG8_SA(b, h) (((b) * 2 + (h)) * HTB)
#define PG8_SB(b, h) ((4 + (b) * 2 + (h)) * HTB)
#define PG8_STAGE(bufoff, gbase, voff) do { _Pragma("unroll") for (int _i = 0; _i < 2; ++_i) \
        __builtin_amdgcn_global_load_lds((const unsigned*)((const char*)(gbase) + (voff)[_i]), (LAS unsigned*)(lds + (bufoff) + ldsw + _i * 8192), 16, 0, 0); } while (0)
#define PG8_LDA(dst, b, h) do { _Pragma("unroll") for (int m = 0; m < 4; ++m) _Pragma("unroll") for (int k = 0; k < 2; ++k) dst[m][k] = *(const LAS bf16x8*)(lds + PG8_SA(b, h) + aoff + m * 2048 + k * 1024); } while (0)
#define PG8_LDB(dst, b, h) do { _Pragma("unroll") for (int n = 0; n < 2; ++n) _Pragma("unroll") for (int k = 0; k < 2; ++k) dst[n][k] = *(const LAS bf16x8*)(lds + PG8_SB(b, h) + boff + n * 2048 + k * 1024); } while (0)
#define PG8_MMA(ai, bj, At, Bt) do { __builtin_amdgcn_s_setprio(1); _Pragma("unroll") for (int m = 0; m < 4; ++m) _Pragma("unroll") for (int n = 0; n < 2; ++n) _Pragma("unroll") for (int k = 0; k < 2; ++k) \
        acc[ai][bj][m][n] = __builtin_amdgcn_mfma_f32_16x16x32_bf16(Bt[n][k], At[m][k], acc[ai][bj][m][n], 0, 0, 0); __builtin_amdgcn_s_setprio(0); } while (0)
#define PG8_WAIT_V(n) asm volatile("s_waitcnt vmcnt(" #n ")" ::: "memory")
#define PG8_WAIT_L(n) asm volatile("s_waitcnt lgkmcnt(" #n ")" ::: "memory")
#define PG8_BAR __builtin_amdgcn_s_barrier()
#define PG8_SCHED __builtin_amdgcn_sched_barrier(0)
    f32x4 acc[2][2][4][2];
#pragma unroll
    for (int a = 0; a < 2; ++a)
#pragma unroll
        for (int b = 0; b < 2; ++b)
#pragma unroll
            for (int m = 0; m < 4; ++m)
#pragma unroll
                for (int n = 0; n < 2; ++n) acc[a][b][m][n] = (f32x4){0.f, 0.f, 0.f, 0.f};
    bf16x8 At[4][2], B0[2][2], B1[2][2];
    const char* cA = cur.a; const char* cB = cur.b;
    PG8_STAGE(PG8_SB(0, 0), cB, voffB); PG8_STAGE(PG8_SA(0, 0), cA, voffA); PG8_STAGE(PG8_SB(0, 1), cB + hstepB, voffB); PG8_STAGE(PG8_SA(0, 1), cA + hstepA, voffA);
    if (wr == 1) PG8_BAR;
    PG8_WAIT_V(4); PG8_BAR;
    PG8_STAGE(PG8_SB(1, 0), cB + kstepB, voffB); PG8_STAGE(PG8_SA(1, 0), cA + kstepA, voffA); PG8_STAGE(PG8_SB(1, 1), cB + hstepB + kstepB, voffB);
    PG8_WAIT_V(6); PG8_BAR;
    for (;;) {
        bool has_next; { GemmDesc g; gd_build(g, load_args(), launder_s(l), p, gi); has_next = gnext(g, c, G, ui + 1, nxt); }
        const char* nA = has_next ? nxt.a : cA; const char* nB = has_next ? nxt.b : cB;
        for (int t = 0; t < nt; t += 2) {
            const bool last = (t == nt - 2);
            const char* a1 = cA + (size_t)(t + 1) * kstepA;
            const char* a2 = last ? nA : cA + (size_t)(t + 2) * kstepA; const char* b2 = last ? nB : cB + (size_t)(t + 2) * kstepB;
            const char* a3 = a2 + kstepA; const char* b3 = b2 + kstepB;
            PG8_LDB(B0, 0, 0); PG8_SCHED; PG8_LDA(At, 0, 0); PG8_STAGE(PG8_SA(1, 1), a1 + hstepA, voffA);
            PG8_WAIT_L(8); PG8_BAR; PG8_WAIT_L(0); PG8_MMA(0, 0, At, B0); PG8_BAR; PG8_SCHED;
            PG8_LDB(B1, 0, 1); PG8_STAGE(PG8_SB(0, 0), b2, voffB);
            PG8_BAR; PG8_WAIT_L(0); PG8_MMA(0, 1, At, B1); PG8_BAR;
            PG8_LDA(At, 0, 1); PG8_STAGE(PG8_SA(0, 0), a2, voffA);
            PG8_BAR; PG8_WAIT_L(0); PG8_MMA(1, 0, At, B0); PG8_BAR; PG8_SCHED;
            PG8_STAGE(PG8_SB(0, 1), b2 + hstepB, voffB);
            PG8_WAIT_V(6); PG8_BAR; PG8_MMA(1, 1, At, B1); PG8_BAR;
            PG8_LDB(B0, 1, 0); PG8_SCHED; PG8_LDA(At, 1, 0); PG8_STAGE(PG8_SA(0, 1), a2 + hstepA, voffA);
            PG8_WAIT_L(8); PG8_BAR; PG8_WAIT_L(0); PG8_MMA(0, 0, At, B0); PG8_BAR; PG8_SCHED;
            PG8_LDB(B1, 1, 1); PG8_STAGE(PG8_SB(1, 0), b3, voffB);
            PG8_BAR; PG8_WAIT_L(0); PG8_MMA(0, 1, At, B1); PG8_BAR;
            PG8_LDA(At, 1, 1); PG8_STAGE(PG8_SA(1, 0), a3, voffA);
            PG8_BAR; PG8_WAIT_L(0); PG8_MMA(1, 0, At, B0); PG8_BAR; PG8_SCHED;
            PG8_STAGE(PG8_SB(1, 1), b3 + hstepB, voffB);
            PG8_WAIT_V(6); PG8_BAR; PG8_MMA(1, 1, At, B1); PG8_BAR;
        }
        { GemmDesc g; gd_build(g, load_args(), launder_s(l), p, gi); gemm_epilogue(g, acc, cur, wr, wc, fr, fq); }
        if (!has_next) break;
#pragma unroll
        for (int a = 0; a < 2; ++a)
#pragma unroll
            for (int b = 0; b < 2; ++b)
#pragma unroll
                for (int m = 0; m < 4; ++m)
#pragma unroll
                    for (int n = 0; n < 2; ++n) acc[a][b][m][n] = (f32x4){0.f, 0.f, 0.f, 0.f};
        cur = nxt; cA = nA; cB = nB; ++ui;
    }
    PG8_WAIT_V(0);
    if (wr == 0) PG8_BAR;
    PG8_BAR;
#undef PG8_SA
#undef PG8_SB
#undef PG8_STAGE
#undef PG8_LDA
#undef PG8_LDB
#undef PG8_MMA
#undef PG8_WAIT_V
#undef PG8_WAIT_L
#undef PG8_BAR
#undef PG8_SCHED
}

enum { MAP_ID = 0, MAP_FFN = 1, MAP_TOK = 2, MAP_VT = 3, MAP_MG = 4 };
__device__ __forceinline__ int map_col(int map, int n, float& sc) {
    sc = 1.0f;
    if (map == MAP_ID) return n;
    if (map == MAP_FFN) { const int pn = n >> 8, half = (n >> 7) & 1, idx = n & 127; return half * DFF + pn * 128 + idx; }
    if (map == MAP_MG) return 3608 + n;
    if (map == MAP_VT) { if (n < 512) return 1024 + n; if (n < 640) return 2432 + (n - 512); if (n < 768) return 2688 + (n - 640); if (n < 896) return 3480 + (n - 768); return -1; }
    if (n < 512) { sc = QSCALE; return n; }
    if (n < 1024) return n;
    if (n < 1536) { sc = QSCALE; return 1536 + (n - 1024); }
    if (n < 1792) return 2048 + (n - 1536);
    if (n < 1920) return 2304 + (n - 1792);
    if (n < 2048) return 2560 + (n - 1920);
    if (n < 2560) { sc = QSCALE; return 2840 + (n - 2048); }
    if (n < 2688) return 3352 + (n - 2560);
    if (n < 2712) return 2816 + (n - 2688);
    return -1;
}
__device__ __forceinline__ void transpose_item(const float* W, int ldw, int K, int N, bf16_t* WT, int map, LAS float* scr, int item, int lane) {
    const int nblk = N / 32, kb = item / nblk, nb = item % nblk, k0 = 64 * kb, n0 = 32 * nb;
    float sc; const int sc_col = map_col(map, n0 + (lane & 31), sc);
#pragma unroll 8
    for (int i = 0; i < 32; ++i) { const int kk = 2 * i + (lane >> 5); scr[kk * 33 + (lane & 31)] = sc_col >= 0 ? W[(size_t)(k0 + kk) * ldw + sc_col] * sc : 0.f; }
    asm volatile("s_waitcnt lgkmcnt(0)" ::: "memory");
    const int cch = lane & 7;
#pragma unroll
    for (int j = 0; j < 4; ++j) { const int n = (lane >> 3) + 8 * j; const LAS float* s = scr + (8 * cch) * 33 + n;
        u32x4 o; o.x = pk2(s[0 * 33], s[1 * 33]); o.y = pk2(s[2 * 33], s[3 * 33]); o.z = pk2(s[4 * 33], s[5 * 33]); o.w = pk2(s[6 * 33], s[7 * 33]);
        *(u32x4*)(WT + (size_t)(n0 + n) * K + k0 + 8 * cch) = o; }
    asm volatile("s_waitcnt lgkmcnt(0)" ::: "memory");
}
struct ConvJob { const float* W; int ldw, K, N, map; bf16_t* WT; };
__device__ __forceinline__ void get_job(const Args& a, int l, int j, ConvJob& q) {
    bf16_t* wb = (bf16_t*)(a.ws + WS_W);
    const float* ffn_in = a.in[2] + (size_t)l * 2 * DM * 2 * DFF; const float* ffn_out = a.in[3] + (size_t)l * 2 * DFF * DM;
    const float* w_in = a.in[6] + (size_t)l * DM * DIN;
    const float* w1 = a.in[10] + (size_t)l * 2 * 2048 * 256; const float* w2 = a.in[11] + (size_t)l * 2 * 256 * 64;
    q.map = MAP_ID;
    switch (j) {
    case 0: q.W = ffn_in; q.ldw = 2 * DFF; q.K = DM; q.N = 2 * DFF; q.WT = wb + W_F1A; q.map = MAP_FFN; break;
    case 1: q.W = ffn_in + (size_t)DM * 2 * DFF; q.ldw = 2 * DFF; q.K = DM; q.N = 2 * DFF; q.WT = wb + W_F2A; q.map = MAP_FFN; break;
    case 2: q.W = ffn_out; q.ldw = DM; q.K = DFF; q.N = DM; q.WT = wb + W_F1B; break;
    case 3: q.W = ffn_out + (size_t)DFF * DM; q.ldw = DM; q.K = DFF; q.N = DM; q.WT = wb + W_F2B; break;
    case 4: q.W = w_in; q.ldw = DIN; q.K = DM; q.N = 2816; q.WT = wb + W_TOK; q.map = MAP_TOK; break;
    case 5: q.W = w_in; q.ldw = DIN; q.K = DM; q.N = 1024; q.WT = wb + W_VT; q.map = MAP_VT; break;
    case 6: q.W = w_in; q.ldw = DIN; q.K = DM; q.N = 3072; q.WT = wb + W_MG; q.map = MAP_MG; break;
    case 7: q.W = a.in[13] + (size_t)l * 1536 * DM; q.ldw = DM; q.K = 1536; q.N = DM; q.WT = wb + W_BR; break;
    case 8: q.W = a.in[14] + (size_t)l * DM * DM; q.ldw = DM; q.K = DM; q.N = DM; q.WT = wb + W_O; break;
    case 9: q.W = a.in[15] + (size_t)l * PLE * DM; q.ldw = DM; q.K = PLE; q.N = DM; q.WT = wb + W_PI; break;
    case 10: q.W = a.in[16] + (size_t)l * DM * DM; q.ldw = DM; q.K = DM; q.N = DM; q.WT = wb + W_PG; break;
    case 11: q.W = w1; q.ldw = 256; q.K = 2048; q.N = 256; q.WT = wb + W_C1; break;
    case 12: q.W = w1 + 2048 * 256; q.ldw = 256; q.K = 2048; q.N = 256; q.WT = wb + W_C1 + 256 * 2048; break;
    case 13: q.W = w2; q.ldw = 64; q.K = 256; q.N = 64; q.WT = wb + W_C2; break;
    default: q.W = w2 + 256 * 64; q.ldw = 64; q.K = 256; q.N = 64; q.WT = wb + W_C2 + 64 * 256; break;
    }
}
__device__ __forceinline__ void convert_layer(const Args& a, int l, LAS unsigned char* lds, int G) {
    const int tid = my_tid(), lane = tid & 63, wave = tid >> 6;
    LAS float* scr = (LAS float*)(lds + wave * 8448);
    const int gw = blockIdx.x * 8 + wave, NGW = G * 8;
#pragma unroll 1
    for (int j = 0; j < 15; ++j) {
        ConvJob q; get_job(a, l, j, q);
        const int items = (q.K / 64) * (q.N / 32);
#pragma unroll 1
        for (int it = gw; it < items; it += NGW) transpose_item(q.W, q.ldw, q.K, q.N, q.WT, q.map, scr, it, lane);
    }
    { const float* p = a.in[1] + (size_t)l * T * PLE; bf16_t* pb = (bf16_t*)(a.ws + WS_PB);
#pragma unroll 1
      for (size_t i = ((size_t)blockIdx.x * 512 + tid) * 8; i < (size_t)T * PLE; i += (size_t)G * 512 * 8) {
          const f32x4 v0 = *(const f32x4*)(p + i), v1 = *(const f32x4*)(p + i + 4);
          u32x4 w; w.x = pk2(v0[0], v0[1]); w.y = pk2(v0[2], v0[3]); w.z = pk2(v1[0], v1[1]); w.w = pk2(v1[2], v1[3]); *(u32x4*)(pb + i) = w; } }
    if (blockIdx.x < 64) { const float* w1 = a.in[10] + (size_t)l * 2 * 2048 * 256;
        const int fc = blockIdx.x, n = tid >> 8, h = tid & 255; const float* pos = a.in[9] + (size_t)l * 2 * 2048 + n * 2048 + fc * 32; const float* w = w1 + (size_t)n * 2048 * 256 + (size_t)(fc * 32) * 256 + h;
        float s = 0.f;
#pragma unroll 8
        for (int f = 0; f < 32; ++f) s += pos[f] * w[(size_t)f * 256];
        ((float*)(a.ws + WS_CBP))[fc * 512 + tid] = s; }
}

__device__ __forceinline__ void ln_phase(const float* src, const float* gam, const float* bet, float* dst, bf16_t* dstb, int G) {
    const int tid_ = my_tid(), lane = tid_ & 63, wave = tid_ >> 6;
    f32x4 gv[4], bv[4];
#pragma unroll
    for (int j = 0; j < 4; ++j) { gv[j] = *(const f32x4*)(gam + 4 * lane + 256 * j); bv[j] = *(const f32x4*)(bet + 4 * lane + 256 * j); }
    for (int row0 = blockIdx.x * 8 + wave; row0 < T; row0 += G * 16) {
        f32x4 v[2][4]; float s[2] = {0.f, 0.f};
#pragma unroll
        for (int q = 0; q < 2; ++q) { const float* xr = src + (size_t)(row0 + q * G * 8) * DM + 4 * lane;
#pragma unroll
            for (int j = 0; j < 4; ++j) { v[q][j] = *(const f32x4*)(xr + 256 * j); s[q] += (v[q][j][0] + v[q][j][1]) + (v[q][j][2] + v[q][j][3]); } }
#pragma unroll
        for (int q = 0; q < 2; ++q) {
            const int row = row0 + q * G * 8;
            const float mean = wave_sum(s[q]) * (1.f / DM); float s2 = 0.f;
#pragma unroll
            for (int j = 0; j < 4; ++j) { v[q][j] = v[q][j] - mean; s2 += (v[q][j][0] * v[q][j][0] + v[q][j][1] * v[q][j][1]) + (v[q][j][2] * v[q][j][2] + v[q][j][3] * v[q][j][3]); }
            const float rstd = 1.0f / sqrtf(wave_sum(s2) * (1.f / DM) + 1e-5f);
#pragma unroll
            for (int j = 0; j < 4; ++j) { const f32x4 o = v[q][j] * rstd * gv[j] + bv[j]; *(f32x4*)(dst + (size_t)row * DM + 4 * lane + 256 * j) = o;
                u32x2 w; w.x = pk2(o[0], o[1]); w.y = pk2(o[2], o[3]); *(u32x2*)(dstb + (size_t)row * DM + 4 * lane + 256 * j) = w; }
        }
    }
}

constexpr int AT_KB0 = 0, AT_VB0 = 17408, AT_BUF = 35840, AT_X = 71680, AT_MISC = 137216;
template <int DV> struct FlashSt { f32x16 o[DV / 32]; float m, l; };
template <int KW, int DV> struct StageRegs { u32x4 k[KW / 64]; u32x4 v[DV / 64]; };

template <int KW, int DV>
__device__ __forceinline__ void stage_load(StageRegs<KW, DV>& r, const bf16_t* kp, size_t ldk, const bf16_t* vp, size_t ldv, int tid) {
#pragma unroll
    for (int i = 0; i < KW / 64; ++i) { const int idx = tid + i * 512, key = idx / (KW / 8), ch = idx % (KW / 8); r.k[i] = *(const u32x4*)(kp + (size_t)key * ldk + ch * 8); }
#pragma unroll
    for (int i = 0; i < DV / 64; ++i) { const int idx = tid + i * 512, d = idx >> 3, kc = idx & 7; r.v[i] = *(const u32x4*)(vp + (size_t)d * ldv + kc * 8); }
}
template <int KW, int DV>
__device__ __forceinline__ void stage_store(const StageRegs<KW, DV>& r, LAS unsigned char* kb, LAS unsigned char* vb, int tid) {
    constexpr int KSTR = KW * 2 + 16, VSTR = 144;
#pragma unroll
    for (int i = 0; i < KW / 64; ++i) { const int idx = tid + i * 512, key = idx / (KW / 8), ch = idx % (KW / 8); *(LAS u32x4*)(kb + key * KSTR + ch * 16) = r.k[i]; }
#pragma unroll
    for (int i = 0; i < DV / 64; ++i) { const int idx = tid + i * 512, d = idx >> 3, kc = idx & 7; LAS unsigned char* p = vb + d * VSTR + (kc >> 1) * 32 + (kc & 1) * 8;
        *(LAS u32x2*)(p) = (u32x2){r.v[i].x, r.v[i].y}; *(LAS u32x2*)(p + 16) = (u32x2){r.v[i].z, r.v[i].w}; }
}
__device__ __forceinline__ bf16x8 pack8(const f32x16& s, int o) {
    u32x4 w; w.x = pk2(s[o + 0], s[o + 1]); w.y = pk2(s[o + 2], s[o + 3]); w.z = pk2(s[o + 4], s[o + 5]); w.w = pk2(s[o + 6], s[o + 7]);
    return __builtin_bit_cast(bf16x8, w);
}

template <int KW, int DV>
__device__ __forceinline__ void flash_block(FlashSt<DV>& st, const bf16x8 (&qf)[4], const LAS unsigned char* kb, const LAS unsigned char* vb, int koff, int kb0,
                                            int t, int tmin, int tmax, int W, float slope2, bool selok, bool anymask, int lane) {
    constexpr int KSTR = KW * 2 + 16, VSTR = 144;
    const int r = lane & 31, hf = lane >> 5;
    f32x16 s0 = zero16(), s1 = zero16();
    const LAS unsigned char* kp = kb + r * KSTR + koff + hf * 16;
#pragma unroll
    for (int ks = 0; ks < 4; ++ks) {
        const bf16x8 k0 = *(const LAS bf16x8*)(kp + ks * 32), k1 = *(const LAS bf16x8*)(kp + 32 * KSTR + ks * 32);
        s0 = mfma32(k0, qf[ks], s0); s1 = mfma32(k1, qf[ks], s1);
    }
    const int rel = t - kb0 - 4 * hf; const float relf = (float)rel;
    const bool edge = anymask || (kb0 + 63 > tmin) || (kb0 <= tmax - W);
    float mx = NINF;
#pragma unroll
    for (int i = 0; i < 16; ++i) {
        const int kc = (i & 3) + 8 * (i >> 2);
        float v0 = s0[i] - slope2 * (relf - (float)kc), v1 = s1[i] - slope2 * (relf - (float)(kc + 32));
        if (edge) { if (!(selok && kc <= rel && kc > rel - W)) v0 = NINF; if (!(selok && kc + 32 <= rel && kc + 32 > rel - W)) v1 = NINF; }
        s0[i] = v0; s1[i] = v1; mx = fmaxf(mx, fmaxf(v0, v1));
    }
    mx = fmaxf(mx, __shfl_xor(mx, 32));
    const float mnew = fmaxf(st.m, mx), msafe = (mnew == NINF) ? 0.f : mnew;
    const float alpha = fexp2(st.m - msafe);
    float ls = 0.f;
#pragma unroll
    for (int i = 0; i < 16; ++i) { s0[i] = fexp2(s0[i] - msafe); s1[i] = fexp2(s1[i] - msafe); ls += s0[i] + s1[i]; }
    st.l = st.l * alpha + ls; st.m = mnew;
#pragma unroll
    for (int db = 0; db < DV / 32; ++db) st.o[db] = st.o[db] * alpha;
    bf16x8 p[4]; p[0] = pack8(s0, 0); p[1] = pack8(s0, 8); p[2] = pack8(s1, 0); p[3] = pack8(s1, 8);
    const LAS unsigned char* vp = vb + r * VSTR + hf * 16;
#pragma unroll
    for (int db = 0; db < DV / 32; ++db)
#pragma unroll
        for (int g4 = 0; g4 < 4; ++g4) { const bf16x8 vf = *(const LAS bf16x8*)(vp + db * 32 * VSTR + g4 * 32); st.o[db] = mfma32(vf, p[g4], st.o[db]); }
}

template <int KW, int DV>
__device__ __forceinline__ void flash_run(LAS unsigned char* lds, FlashSt<DV>& st, const bf16x8 (&qf)[4], const bf16_t* kbase, size_t ldk, const bf16_t* vbase, size_t ldv,
                                          unsigned bits, unsigned selmask, bool use_sel, int t, int tmin, int tmax, int W, float slope2, int koff) {
    const int tid = my_tid(), lane = tid & 63;
    unsigned rem = bits;
    if (!rem) return;
    StageRegs<KW, DV> sr;
    int j = __builtin_ctz(rem); rem &= rem - 1;
    stage_load<KW, DV>(sr, kbase + (size_t)j * 64 * ldk, ldk, vbase + j * 64, ldv, tid);
    stage_store<KW, DV>(sr, lds + AT_KB0, lds + AT_VB0, tid);
    __syncthreads();
    int buf = 0;
    for (;;) {
        const int jn = rem ? __builtin_ctz(rem) : -1;
        if (jn >= 0) stage_load<KW, DV>(sr, kbase + (size_t)jn * 64 * ldk, ldk, vbase + jn * 64, ldv, tid);
        const int kb0 = j * 64;
        const bool skip = (kb0 > tmax) || (kb0 + 63 <= tmin - W);
        if (!skip) {
            const bool selok = use_sel ? ((selmask >> j) & 1u) : true;
            flash_block<KW, DV>(st, qf, lds + AT_KB0 + buf * AT_BUF, lds + AT_VB0 + buf * AT_BUF, koff, kb0, t, tmin, tmax, W, slope2, selok, use_sel, lane);
        }
        if (jn < 0) break;
        stage_store<KW, DV>(sr, lds + AT_KB0 + (buf ^ 1) * AT_BUF, lds + AT_VB0 + (buf ^ 1) * AT_BUF, tid);
        __syncthreads();
        buf ^= 1; j = jn; rem &= rem - 1;
    }
    __syncthreads();
}
__device__ __forceinline__ void load_q(bf16x8 (&qf)[4], const bf16_t* qrow, int hf) {
#pragma unroll
    for (int ks = 0; ks < 4; ++ks) qf[ks] = *(const bf16x8*)(qrow + ks * 16 + hf * 8);
}
template <int DV> __device__ __forceinline__ void flash_init(FlashSt<DV>& st) {
#pragma unroll
    for (int db = 0; db < DV / 32; ++db)
#pragma unroll
        for (int i = 0; i < 16; ++i) st.o[db][i] = 0.f;
    st.m = NINF; st.l = 0.f;
}
__device__ __forceinline__ unsigned range_bits(int lo, int hi) {
    const unsigned hi_m = (hi >= 31) ? 0xffffffffu : ((1u << (hi + 1)) - 1u); return hi_m & ~((1u << lo) - 1u);
}
__device__ __forceinline__ void store_o64(const f32x16 (&o)[2], bf16_t* orow, int hf) {
#pragma unroll
    for (int db = 0; db < 2; ++db)
#pragma unroll
        for (int q4 = 0; q4 < 4; ++q4) { u32x2 w; w.x = pk2(o[db][4 * q4], o[db][4 * q4 + 1]); w.y = pk2(o[db][4 * q4 + 2], o[db][4 * q4 + 3]);
            *(u32x2*)(orow + db * 32 + 8 * q4 + 4 * hf) = w; }
}

__device__ __forceinline__ void diff_item(const Args& a, int l, LAS unsigned char* lds, int b, int h, int qi) {
    const int tid = my_tid(), lane = tid & 63, wave = tid >> 6, mp = wave >> 2, wq = wave & 3, r = lane & 31, hf = lane >> 5;
    const bf16_t* qkv = (const bf16_t*)(a.ws + WS_A); const bf16_t* vt = (const bf16_t*)(a.ws + WS_VT); bf16_t* O = (bf16_t*)(a.ws + WS_B);
    const int q0 = qi * 128, tmin = q0 + wq * 32, tmax = tmin + 31, t = tmin + r;
    const float slope2 = fexp2(-2.0f * (float)(h + 1)) * LOG2E;
    const float lambda_init = 0.8f - 0.6f * __expf(-0.3f * (float)l);
    const float* lam = a.in[7] + l * 256;
    const float lam_full = __expf(wave_sum(lam[lane] * lam[64 + lane])) - __expf(wave_sum(lam[128 + lane] * lam[192 + lane])) + lambda_init;
    bf16x8 qf[4]; load_q(qf, qkv + (size_t)(b * SEQ + t) * LDQ + QA + h * 128 + mp * 64, hf);
    FlashSt<128> st; flash_init<128>(st);
    flash_run<128, 128>(lds, st, qf, qkv + (size_t)b * SEQ * LDQ + KA + h * 128, LDQ, vt + (size_t)(VA + h * 128) * T + (size_t)b * SEQ, T,
                        range_bits(0, 2 * qi + 1), 0u, false, t, tmin, tmax, 1 << 28, slope2, mp * 128);
    const float lt = st.l + __shfl_xor(st.l, 32); const float inv = 1.0f / lt;
    LAS float* xb = (LAS float*)(lds + AT_X) + wq * 4096 + lane;
    if (mp == 1) {
        const float f = inv * lam_full;
#pragma unroll
        for (int db = 0; db < 4; ++db)
#pragma unroll
            for (int i = 0; i < 16; ++i) xb[(db * 16 + i) * 64] = st.o[db][i] * f;
    }
    __syncthreads();
    if (mp == 0) {
        float ss = 0.f;
#pragma unroll
        for (int db = 0; db < 4; ++db)
#pragma unroll
            for (int i = 0; i < 16; ++i) { const float v = st.o[db][i] * inv - xb[(db * 16 + i) * 64]; st.o[db][i] = v; ss += v * v; }
        ss += __shfl_xor(ss, 32);
        const float rs = (DBG_ZERO & 1) ? 0.f : (1.0f / sqrtf(ss * (1.0f / 128.0f) + 1e-5f)) * (1.0f - lambda_init);
        const float* sg = a.in[8] + l * 128; bf16_t* orow = O + (size_t)(b * SEQ + t) * 1536 + h * 128;
#pragma unroll
        for (int db = 0; db < 4; ++db)
#pragma unroll
            for (int q4 = 0; q4 < 4; ++q4) { const int d = db * 32 + 8 * q4 + 4 * hf; const f32x4 gg = *(const f32x4*)(sg + d);
                u32x2 w; w.x = pk2(st.o[db][4 * q4] * rs * gg[0], st.o[db][4 * q4 + 1] * rs * gg[1]); w.y = pk2(st.o[db][4 * q4 + 2] * rs * gg[2], st.o[db][4 * q4 + 3] * rs * gg[3]);
                *(u32x2*)(orow + d) = w; }
    }
    __syncthreads();
}

__device__ __forceinline__ void swa_item(const Args& a, int l, LAS unsigned char* lds, int b, int g, int tb) {
    const int tid = my_tid(), lane = tid & 63, wave = tid >> 6, hd = wave & 3, th = wave >> 2, r = lane & 31, hf = lane >> 5;
    const bf16_t* qkv = (const bf16_t*)(a.ws + WS_A); const bf16_t* vt = (const bf16_t*)(a.ws + WS_VT); bf16_t* O = (bf16_t*)(a.ws + WS_B);
    const int head = g * 4 + hd, tmin = tb * 64 + th * 32, tmax = tmin + 31, t = tmin + r;
    const float slope2 = fexp2(-(float)(head + 1)) * LOG2E;
    bf16x8 qf[4]; load_q(qf, qkv + (size_t)(b * SEQ + t) * LDQ + QC + head * 64, hf);
    FlashSt<64> st; flash_init<64>(st);
    flash_run<64, 64>(lds, st, qf, qkv + (size_t)b * SEQ * LDQ + KCC + g * 64, LDQ, vt + (size_t)(VC + g * 64) * T + (size_t)b * SEQ, T,
                      range_bits(tb >= 2 ? tb - 2 : 0, tb), 0u, false, t, tmin, tmax, 128, slope2, 0);
    const float sink = a.in[12][l * 8 + head];
    const float lt = st.l + __shfl_xor(st.l, 32) + ((DBG_ZERO & 8) ? 0.f : fexp2(sink * LOG2E - st.m)); const float inv = 1.0f / lt;
    st.o[0] = st.o[0] * ((DBG_ZERO & 4) ? 0.f : inv); st.o[1] = st.o[1] * ((DBG_ZERO & 4) ? 0.f : inv);
    const int tp = (t & 127) * 16 + (t >> 7);
    store_o64(st.o, O + (size_t)(b * SEQ + tp) * 1536 + 1024 + head * 64, hf);
}

__device__ __forceinline__ void nsa_item(const Args& a, LAS unsigned char* lds, int b, int g, int tb) {
    const int tid = my_tid(), lane = tid & 63, wave = tid >> 6, hd = wave & 3, th = wave >> 2, r = lane & 31, hf = lane >> 5;
    const bf16_t* qkv = (const bf16_t*)(a.ws + WS_A); const bf16_t* vt = (const bf16_t*)(a.ws + WS_VT); bf16_t* O = (bf16_t*)(a.ws + WS_B);
    const bf16_t* KCb = (const bf16_t*)(a.ws + WS_KC) + (size_t)(b * 2 + g) * 128 * 64; const bf16_t* VCb = (const bf16_t*)(a.ws + WS_VCT) + (size_t)(b * 2 + g) * 64 * 128;
    const int head = g * 4 + hd, tl = th * 32 + r, tmin = tb * 64 + th * 32, tmax = tmin + 31, t = tmin + r;
    const float slope2 = fexp2(-(float)(head + 1)) * LOG2E;
    const bf16_t* trow = qkv + (size_t)(b * SEQ + t) * LDQ;
    bf16x8 qf[4]; load_q(qf, trow + QB + head * 64, hf);
    const float g0 = sigmoidf_(bf2f(trow[BG + head])), g1 = sigmoidf_(bf2f(trow[BG + 8 + head])), g2 = sigmoidf_(bf2f(trow[BG + 16 + head]));
    f32x16 out[2];
    const int ncb = (tb >= 16) ? 2 : 1;
    f32x16 sc[4];
#pragma unroll
    for (int sb = 0; sb < 4; ++sb) sc[sb] = zero16();
#pragma unroll
    for (int cb = 0; cb < 2; ++cb) if (cb < ncb) {
        const bf16_t* kp = KCb + (size_t)(cb * 64 + r) * 64 + hf * 8;
#pragma unroll
        for (int ks = 0; ks < 4; ++ks) { const bf16x8 k0 = *(const bf16x8*)(kp + ks * 16), k1 = *(const bf16x8*)(kp + 32 * 64 + ks * 16);
            sc[2 * cb] = mfma32(k0, qf[ks], sc[2 * cb]); sc[2 * cb + 1] = mfma32(k1, qf[ks], sc[2 * cb + 1]); }
    }
    float mx = NINF;
#pragma unroll
    for (int sb = 0; sb < 4; ++sb)
#pragma unroll
        for (int i = 0; i < 16; ++i) { const int c = sb * 32 + (i & 3) + 8 * (i >> 2) + 4 * hf; const int dist = t - 16 * c - 31;
            const float v = (dist >= 0 && sb < 2 * ncb) ? sc[sb][i] - slope2 * (float)dist : NINF; sc[sb][i] = v; mx = fmaxf(mx, v); }
    mx = fmaxf(mx, __shfl_xor(mx, 32));
    const float msafe = (mx == NINF) ? 0.f : mx;
    float ls = 0.f;
#pragma unroll
    for (int sb = 0; sb < 4; ++sb)
#pragma unroll
        for (int i = 0; i < 16; ++i) { const float p = fexp2(sc[sb][i] - msafe); sc[sb][i] = p; ls += p; }
    ls += __shfl_xor(ls, 32);
    const float invl = ls > 0.f ? 1.0f / ls : 0.f;
#pragma unroll
    for (int sb = 0; sb < 4; ++sb) sc[sb] = sc[sb] * invl;
    {
        LAS float* sl = (LAS float*)(lds + AT_X) + (hd * 64 + tl) * 32;
        float xprev = 0.f;
#pragma unroll
        for (int sb = 0; sb < 4; ++sb)
#pragma unroll
            for (int q4 = 0; q4 < 4; ++q4) {
                const float h3 = 0.5f * sc[sb][4 * q4 + 3];
                const float mainv = sc[sb][4 * q4] + sc[sb][4 * q4 + 1] + sc[sb][4 * q4 + 2] + h3;
                const float x = __shfl_xor(h3, 32);
                sl[sb * 8 + 2 * q4 + hf] = mainv + (hf ? x : xprev);
                xprev = x;
            }
    }
    out[0] = zero16(); out[1] = zero16();
#pragma unroll
    for (int cb = 0; cb < 2; ++cb) if (cb < ncb) {
        bf16x8 p[4]; p[0] = pack8(sc[2 * cb], 0); p[1] = pack8(sc[2 * cb], 8); p[2] = pack8(sc[2 * cb + 1], 0); p[3] = pack8(sc[2 * cb + 1], 8);
        const bf16_t* vp = VCb + (size_t)r * 128 + cb * 64 + hf * 4;
#pragma unroll
        for (int db = 0; db < 2; ++db)
#pragma unroll
            for (int g4 = 0; g4 < 4; ++g4) {
                const u32x2 lo = *(const u32x2*)(vp + db * 32 * 128 + g4 * 16), hi = *(const u32x2*)(vp + db * 32 * 128 + g4 * 16 + 8);
                const u32x4 w = (u32x4){lo.x, lo.y, hi.x, hi.y};
                out[db] = mfma32(__builtin_bit_cast(bf16x8, w), p[g4], out[db]); }
    }
    out[0] = out[0] * g0; out[1] = out[1] * g0;

    __syncthreads();
    LAS unsigned* selm = (LAS unsigned*)(lds + AT_MISC + 64);
    {
        const LAS float* sl = (const LAS float*)(lds + AT_X);
#pragma unroll 1
        for (int it = 0; it < 4; ++it) {
            const int tok = it * 16 + wave * 2 + hf, j = r;
            float s = ((sl[(0 * 64 + tok) * 32 + j] + sl[(1 * 64 + tok) * 32 + j]) + sl[(2 * 64 + tok) * 32 + j]) + sl[(3 * 64 + tok) * 32 + j];
            if (j == 0 || j == tb || j == tb - 1) s = 1e4f;
            if (j > tb) s = -1.0f;
            int rank = 0;
#pragma unroll
            for (int jj = 0; jj < 32; ++jj) { const float o = __shfl(s, (lane & 32) | jj); rank += (o > s || (o == s && jj < j)) ? 1 : 0; }
            const unsigned long long bal = __ballot(rank < 16);
            if (r == 0) selm[tok] = hf ? (unsigned)(bal >> 32) : (unsigned)bal;
        }
    }
    __syncthreads();
    if (hd == 0 && hf == 0) ((unsigned*)(a.ws + WS_SEL))[(size_t)(b * 2 + g) * SEQ + t] = selm[tl];
    {
        FlashSt<64> st; flash_init<64>(st);
        flash_run<64, 64>(lds, st, qf, qkv + (size_t)b * SEQ * LDQ + KWC + g * 64, LDQ, vt + (size_t)(VW + g * 64) * T + (size_t)b * SEQ, T,
                          range_bits(tb >= 8 ? tb - 8 : 0, tb), 0u, false, t, tmin, tmax, 512, slope2, 0);
        const float lt = st.l + __shfl_xor(st.l, 32); const float f = 1.0f / lt;
        st.o[0] = st.o[0] * f; st.o[1] = st.o[1] * f;
        const int tp = (t & 127) * 16 + (t >> 7);
        store_o64(st.o, (bf16_t*)(a.ws + WS_WIN) + (size_t)(b * SEQ + tp) * 512 + head * 64, hf);
    }
    store_o64(out, O + (size_t)(b * SEQ + t) * 1536 + 512 + head * 64, hf);
}

__device__ __forceinline__ void nsa_item_b(const Args& a, LAS unsigned char* lds, int b, int g, int tb) {
    const int tid = my_tid(), lane = tid & 63, wave = tid >> 6, hd = wave & 3, th = wave >> 2, r = lane & 31, hf = lane >> 5;
    const bf16_t* qkv = (const bf16_t*)(a.ws + WS_A); const bf16_t* vt = (const bf16_t*)(a.ws + WS_VT); bf16_t* O = (bf16_t*)(a.ws + WS_B);
    const unsigned* sel = (const unsigned*)(a.ws + WS_SEL) + (size_t)(b * 2 + g) * SEQ + tb * 64;
    const int head = g * 4 + hd, tl = th * 32 + r, tmin = tb * 64 + th * 32, tmax = tmin + 31, t = tmin + r;
    const float slope2 = fexp2(-(float)(head + 1)) * LOG2E;
    bf16x8 qf[4]; load_q(qf, qkv + (size_t)(b * SEQ + t) * LDQ + QB + head * 64, hf);
    const unsigned selmask = sel[tl];
    unsigned um = sel[lane];
#pragma unroll
    for (int o = 1; o < 64; o <<= 1) um |= __shfl_xor(um, o);
    um = __builtin_amdgcn_readfirstlane(um) & range_bits(0, tb);
    FlashSt<64> st; flash_init<64>(st);
    flash_run<64, 64>(lds, st, qf, qkv + (size_t)b * SEQ * LDQ + KS + g * 64, LDQ, vt + (size_t)(VS + g * 64) * T + (size_t)b * SEQ, T,
                      um, selmask, true, t, tmin, tmax, 1 << 28, slope2, 0);
    const float lt = st.l + __shfl_xor(st.l, 32); const float f = lt > 0.f ? 1.0f / lt : 0.f;
    const int tp = (t & 31) * 64 + (t >> 5);
    const size_t rowp = (size_t)(b * SEQ + tp);
    const bf16_t* trow = qkv + rowp * LDQ;
    const float g1 = sigmoidf_(bf2f(trow[BG + 8 + head])) * f, g2 = sigmoidf_(bf2f(trow[BG + 16 + head]));
    bf16_t* orow = O + rowp * 1536 + 512 + head * 64; const bf16_t* wrow = (const bf16_t*)(a.ws + WS_WIN) + rowp * 512 + head * 64;
#pragma unroll
    for (int db = 0; db < 2; ++db)
#pragma unroll
        for (int q4 = 0; q4 < 4; ++q4) { const int d = db * 32 + 8 * q4 + 4 * hf;
            const u32x2 cw = *(const u32x2*)(orow + d), ww = *(const u32x2*)(wrow + d);
            const float v0 = bflo(cw.x) + g1 * st.o[db][4 * q4] + g2 * bflo(ww.x), v1 = bfhi(cw.x) + g1 * st.o[db][4 * q4 + 1] + g2 * bfhi(ww.x);
            const float v2 = bflo(cw.y) + g1 * st.o[db][4 * q4 + 2] + g2 * bflo(ww.y), v3 = bfhi(cw.y) + g1 * st.o[db][4 * q4 + 3] + g2 * bfhi(ww.y);
            u32x2 w; w.x = pk2(v0, v1); w.y = pk2(v2, v3); *(u32x2*)(orow + d) = w; }
}

__device__ __forceinline__ void attn_phase(const Args& a, int l, LAS unsigned char* lds, int pass, int rep = 0) {
    unsigned* ctr = (unsigned*)(a.ws + WS_CTL) + 64 * (l + 1) + 32 * pass + 8 * rep;
    LAS unsigned* qslot = (LAS unsigned*)(lds + AT_MISC);
    const unsigned nitems = pass ? 1024u : 3072u;
    for (;;) {
        if (my_tid() == 0) *qslot = atomicAdd(ctr, 1u);
        __syncthreads();
        const unsigned q = *qslot;
        __syncthreads();
        if (q >= nitems) break;
        if (pass) { nsa_item_b(a, lds, (q & 31) >> 1, q & 1, 31 - (q >> 5)); continue; }
        if (q < 2048u) {
            const int s = q >> 6, rr = q & 63;
            if (rr < 32) nsa_item(a, lds, rr >> 1, rr & 1, 31 - s);
            else { const int bh = (s & 1) * 32 + (rr - 32); diff_item(a, l, lds, bh >> 2, bh & 3, 15 - (s >> 1)); }
        } else { const int x = q - 2048; swa_item(a, l, lds, x >> 6, (x >> 5) & 1, x & 31); }
    }
}

__device__ __forceinline__ void cmp_gemm2(const Args& a) {
    const int c = blockIdx.x; if (c >= 32) return;
    const int tid_ = my_tid(), n = c >> 4, rt = c & 15, lane = tid_ & 63, wave = tid_ >> 6, r = lane & 31, hf = lane >> 5;
    const bf16_t* hid = (const bf16_t*)(a.ws + WS_HID) + ((size_t)n * 4096 + rt * 256 + wave * 32) * 256;
    const bf16_t* w2 = (const bf16_t*)(a.ws + WS_W) + W_C2 + n * 64 * 256;
    f32x16 acc[2]; acc[0] = zero16(); acc[1] = zero16();
#pragma unroll 4
    for (int ks = 0; ks < 16; ++ks) {
        const bf16x8 hf8 = *(const bf16x8*)(hid + (size_t)r * 256 + ks * 16 + hf * 8);
        const bf16x8 w0 = *(const bf16x8*)(w2 + (size_t)r * 256 + ks * 16 + hf * 8), w1 = *(const bf16x8*)(w2 + (size_t)(32 + r) * 256 + ks * 16 + hf * 8);
        acc[0] = mfma32(hf8, w0, acc[0]); acc[1] = mfma32(hf8, w1, acc[1]);
    }
    const int R0 = rt * 256 + wave * 32, gg = R0 >> 11, bb = (R0 >> 7) & 15, cc0 = R0 & 127;
    if (n == 0) {
        bf16_t* kp = (bf16_t*)(a.ws + WS_KC) + ((size_t)(bb * 2 + gg) * 128 + cc0 + 4 * hf) * 64 + r;
#pragma unroll
        for (int db = 0; db < 2; ++db)
#pragma unroll
            for (int i = 0; i < 16; ++i) kp[((i & 3) + 8 * (i >> 2)) * 64 + db * 32] = (bf16_t)(pk2(acc[db][i], 0.f) & 0xffffu);
    } else {
#pragma unroll
        for (int db = 0; db < 2; ++db) {
            bf16_t* vp = (bf16_t*)(a.ws + WS_VCT) + ((size_t)(bb * 2 + gg) * 64 + db * 32 + r) * 128 + cc0 + 4 * hf;
#pragma unroll
            for (int i = 0; i < 16; ++i) vp[(i & 3) + 8 * (i >> 2)] = (bf16_t)(pk2(acc[db][i], 0.f) & 0xffffu);
        }
    }
}


constexpr int NPH = 31;
__device__ __forceinline__ void gd_build(GemmDesc& g, const Args& a, int l, int p, int gi) {
    unsigned char* ws = a.ws;
    bf16_t* wb = (bf16_t*)(ws + WS_W); bf16_t* xb = (bf16_t*)(ws + WS_XB);
    bf16_t* RA = (bf16_t*)(ws + WS_A); bf16_t* hb = (bf16_t*)(ws + WS_VT); float* V = (float*)(ws + WS_B);
    const size_t T1K = (size_t)256 * 1024 * 2;
    g.A = (const char*)xb; g.Bt = nullptr; g.lda = 1024; g.ldb = 1024; g.ksA = 128; g.nt = 16; g.nM = 128; g.nN = 4; g.nz = 1; g.cmp = 0; g.perm = 1; g.mode = EP_BF16;
    g.a_tile = T1K; g.b_tile = T1K; g.a_z = 0; g.b_z = 0; g.f0 = V; g.xres = a.out; g.o16 = RA; g.bias = nullptr; g.ldc = 1024; g.scale = 1.f;
    switch (p) {
    case 0: case 11: g.Bt = (const char*)(wb + (p == 0 ? W_F1A : W_F2A)); g.nN = 22; g.mode = EP_SWIGLU; g.ldc = DFF; break;
    case 1: case 12: g.A = (const char*)RA; g.lda = DFF; g.Bt = (const char*)(wb + (p == 1 ? W_F1B : W_F2B)); g.ldb = DFF; g.nt = 44;
        g.a_tile = (size_t)256 * DFF * 2; g.b_tile = (size_t)256 * DFF * 2; g.mode = EP_RES; g.perm = 0; g.xres = (l == 0 && p == 1) ? a.in[0] : a.out; g.scale = 0.5f; g.o16 = (p == 12) ? hb : nullptr; break;
    case 3:
        if (gi == 0) { g.Bt = (const char*)(wb + W_TOK); g.nN = 11; g.ldc = LDQ; }
        else { g.A = (const char*)(wb + W_VT); g.Bt = (const char*)xb; g.nM = 4; g.nN = 128; g.o16 = (bf16_t*)(ws + WS_VT); g.ldc = T; }
        break;
    case 4: g.cmp = 1; g.A = (const char*)(RA + KVC); g.lda = 16 * LDQ; g.ksA = LDQ * 2; g.nt = 32; g.a_tile = (size_t)256 * 16 * LDQ * 2;
        g.Bt = (const char*)(wb + W_C1); g.ldb = 2048; g.b_z = (size_t)256 * 2048 * 2; g.mode = EP_GELU; g.o16 = (bf16_t*)(ws + WS_HID); g.ldc = 256; g.bias = (const float*)(ws + WS_CB); break;
    case 7: g.Bt = (const char*)(wb + W_MG); g.nN = 12; g.mode = EP_SIG16; g.ldc = 3072; break;
    case 8: g.A = (const char*)(ws + WS_B); g.lda = 1536; g.Bt = (const char*)(wb + W_BR); g.ldb = 1536; g.nt = 8; g.nz = 3; g.a_tile = (size_t)256 * 1536 * 2; g.b_tile = (size_t)256 * 1536 * 2;
        g.a_z = 1024; g.b_z = 1024; g.mode = EP_BRANCH; g.ldc = 3072; break;
    case 9: g.A = (const char*)RA; g.lda = 3072; g.Bt = (const char*)(wb + W_O); g.a_tile = (size_t)256 * 3072 * 2; g.mode = EP_RES; g.perm = 0; g.o16 = nullptr; break;
    default:
        if (gi == 0) { g.A = (const char*)(ws + WS_PB); g.lda = 256; g.Bt = (const char*)(wb + W_PI); g.ldb = 256; g.nt = 4; g.a_tile = (size_t)256 * 256 * 2; g.b_tile = (size_t)256 * 256 * 2; g.mode = EP_PE16; g.perm = 0; }
        else { g.A = (const char*)hb; g.Bt = (const char*)(wb + W_PG); g.mode = EP_PLEGATE; g.perm = 0; }
        break;
    }
}

__global__ void __launch_bounds__(512) fwd_kernel(Args a_kernarg) {
    extern __shared__ __attribute__((aligned(16))) unsigned char lds_raw[];
    LAS unsigned char* lds = (LAS unsigned char*)lds_raw;
    const int G = gridDim.x, c = blockIdx.x;
    const int ph_lo = a_kernarg.ph_lo, ph_hi = a_kernarg.ph_hi;
#pragma unroll 1
    for (int ph = ph_lo; ph < ph_hi; ++ph) {
        if (ph > ph_lo) {
            asm volatile("s_waitcnt vmcnt(0) lgkmcnt(0)" ::: "memory");
            cg::this_grid().sync();
        }
        const Args a = load_args();
        const int l = ph == 0 ? 0 : (ph - 1) / 15, p = ph == 0 ? -1 : (ph - 1) % 15;
        if (ph == 0) {
            const float* x = a.in[0]; bf16_t* xb = (bf16_t*)(a.ws + WS_XB); const int tid = my_tid();
#pragma unroll 1
            for (size_t i = ((size_t)c * 512 + tid) * 8; i < (size_t)T * DM; i += (size_t)G * 512 * 8) {
                const f32x4 v0 = *(const f32x4*)(x + i), v1 = *(const f32x4*)(x + i + 4);
                u32x4 w; w.x = pk2(v0[0], v0[1]); w.y = pk2(v0[2], v0[3]); w.z = pk2(v1[0], v1[1]); w.w = pk2(v1[2], v1[3]); *(u32x4*)(xb + i) = w; }
        }
        if (p == 2 || p == 10 || p == 14) {
            if (p == 2 && c == 0) { float s = 0.f; const int tid = my_tid(); const float* part = (const float*)(a.ws + WS_CBP);
#pragma unroll 8
                for (int f = 0; f < 64; ++f) s += part[f * 512 + tid];
                ((float*)(a.ws + WS_CB))[tid] = s; }
            const int k = (p == 2) ? 0 : (p == 10 ? 1 : 2);
            ln_phase((const float*)(a.ws + WS_B), a.in[4] + (l * 3 + k) * DM, a.in[5] + (l * 3 + k) * DM, a.out, (bf16_t*)(a.ws + WS_XB), G);
        }
        if (ph == 0 || (p == 14 && l == 0)) convert_layer(a, ph == 0 ? 0 : 1, lds, G);
#ifdef DBG_DOUBLE_C
        if (ph == 0 || (p == 14 && l == 0)) { cg::this_grid().sync(); convert_layer(a, ph == 0 ? 0 : 1, lds, G); }
#endif
        if (p == 5 || p == 6) attn_phase(a, l, lds, p - 5);
#ifdef DBG_DOUBLE_A
        if (p == 5) { cg::this_grid().sync(); attn_phase(a, l, lds, 0, 1); }
#endif
        const int ngemm = (p == 0 || p == 1 || p == 4 || p == 7 || p == 8 || p == 9 || p == 11 || p == 12) ? 1 : ((p == 3 || p == 13) ? 2 : 0);
#pragma unroll 1
        for (int gi = 0; gi < ngemm; ++gi) gemm_phase(lds, l, p, gi, c, G);
#ifdef DBG_DOUBLE_G
        if (p == 0 || p == 1 || p == 3 || p == 7 || p == 11 || p == 12) { cg::this_grid().sync(); for (int gi = 0; gi < ngemm; ++gi) gemm_phase(lds, l, p, gi, c, G); }
#endif
        if (p == 4) { __threadfence(); __syncthreads(); cmp_gemm2(load_args()); }
    }
}

extern "C" void kernel_launch(void* const* d_in, const int* in_sizes, int n_in, void* d_out, int out_size, void* d_ws, size_t ws_size, hipStream_t stream) {
    static int grid = 0;
    if (grid == 0) {
        int dev = 0, cus = 0;
        hipGetDevice(&dev); hipDeviceGetAttribute(&cus, hipDeviceAttributeMultiprocessorCount, dev);
        if (hipFuncSetAttribute((const void*)fwd_kernel, hipFuncAttributeMaxDynamicSharedMemorySize, LDS_BYTES) != hipSuccess) fprintf(stderr, "kernel_launch: hipFuncSetAttribute failed\n");
        int per_cu = 0; hipOccupancyMaxActiveBlocksPerMultiprocessor(&per_cu, (const void*)fwd_kernel, 512, LDS_BYTES); (void)hipGetLastError();
        grid = cus > 0 ? cus : 256;
        if (ws_size < WS_END) { fprintf(stderr, "kernel_launch: workspace too small: %zu < %zu\n", ws_size, (size_t)WS_END); grid = -1; }
        if (n_in != 17) { fprintf(stderr, "kernel_launch: expected 17 inputs\n"); grid = -1; }
    }
    if (grid < 0) return;
    hipMemsetAsync((char*)d_ws + WS_CTL, 0, 4096, stream);
    Args a{};
    for (int i = 0; i < 17; ++i) a.in[i] = (const float*)d_in[i];
    a.out = (float*)d_out; a.ws = (unsigned char*)d_ws;
#if N_LAUNCH_MODE == 0
    a.ph_lo = 0; a.ph_hi = NPH;
    void* args[] = {&a};
    hipError_t e = hipLaunchCooperativeKernel((const void*)fwd_kernel, dim3(grid), dim3(512), args, LDS_BYTES, stream);
    if (e != hipSuccess) fprintf(stderr, "cooperative launch failed: %s (grid %d)\n", hipGetErrorString(e), grid);
#else
    for (int ph = 0; ph < NPH; ++ph) { a.ph_lo = ph; a.ph_hi = ph + 1; hipLaunchKernelGGL(fwd_kernel, dim3(grid), dim3(512), LDS_BYTES, stream, a); }

#endif
}
```
